# Optimizing an MI355X kernel written in HIP

```python
import math
import jax, jax.numpy as jnp
from jax import lax
import numpy as np

D_MODEL = 1024
BATCH = 8
SEQ = 4096
DEPTH = 1

RET_HEADS = 8
RET_DK = 128
RET_DV = 256
RET_CHUNK = 128
ROPE_BASE = 10000.0
CONV_CH = D_MODEL
CONV_WIDTH = 31
D_FF = 2816
LN_EPS = 1e-5

QK_W = RET_HEADS * RET_DK
V_W = RET_HEADS * RET_DV
SPLIT_POINTS = tuple(int(p) for p in np.cumsum([QK_W, QK_W, V_W, V_W, CONV_CH, CONV_CH, D_MODEL]))
IN_W = 2 * QK_W + 2 * V_W + 2 * CONV_CH + 2 * D_MODEL

kernel_name = "hybrid_retention_conformer_macaron_deepnorm"


def layer_norm(x, g, b):
    xf = x.astype(jnp.float32)
    mu = jnp.mean(xf, axis=-1, keepdims=True)
    var = jnp.mean(jnp.square(xf - mu), axis=-1, keepdims=True)
    y = (xf - mu) * lax.rsqrt(var + LN_EPS) * g.astype(jnp.float32) + b.astype(jnp.float32)
    return y.astype(x.dtype)


def swiglu_ffn(h, w_gate, w_up, w_down):
    return (jax.nn.silu(h @ w_gate) * (h @ w_up)) @ w_down


def rotary(x, cos, sin):
    half = x.shape[-1] // 2
    x1, x2 = x[..., :half], x[..., half:]
    return jnp.concatenate([x1 * cos - x2 * sin, x2 * cos + x1 * sin], axis=-1).astype(x.dtype)


def retention_chunkwise(q, k, v):
    b, s, h, dk = q.shape
    dv = v.shape[-1]
    c = RET_CHUNK
    n = s // c
    log_g = jnp.log(1.0 - jnp.exp2(-5.0 - jnp.arange(h, dtype=jnp.float32)))
    idx = jnp.arange(c, dtype=jnp.float32)
    diff = idx[:, None] - idx[None, :]
    decay_mask = jnp.where(diff[None] >= 0,
                           jnp.exp(jnp.maximum(diff, 0.0)[None] * log_g[:, None, None]), 0.0)
    qc = q.reshape(b, n, c, h, dk)
    kc = k.reshape(b, n, c, h, dk)
    vc = v.reshape(b, n, c, h, dv)
    scores = jnp.einsum('bnihd,bnjhd->bnhij', qc, kc) * decay_mask
    intra = jnp.einsum('bnhij,bnjhe->bnihe', scores, vc)
    xi = jnp.exp((idx[:, None] + 1.0) * log_g[None, :])
    zeta = jnp.exp((c - 1.0 - idx)[:, None] * log_g[None, :])
    chunk_decay = jnp.exp(c * log_g)

    def step(state, xs):
        qn, kn, vn = xs
        cross = jnp.einsum('bihd,bhde->bihe', qn, state) * xi[None, :, :, None]
        new_state = chunk_decay[None, :, None, None] * state + jnp.einsum(
            'bjhd,bjhe->bhde', kn * zeta[None, :, :, None], vn)
        return new_state, cross

    state0 = jnp.zeros((b, h, dk, dv), jnp.float32)
    _, cross = lax.scan(step, state0, (jnp.moveaxis(qc, 1, 0), jnp.moveaxis(kc, 1, 0), jnp.moveaxis(vc, 1, 0)))
    cross = jnp.moveaxis(cross, 0, 1)
    return (intra + cross).reshape(b, s, h, dv)


def hybrid_mixer(h, w_in, b_in, ret_gn_g, conv_k, conv_b, conv_ln_g, conv_ln_b,
                 w_ret_o, w_conv_o, w_out, cos, sin):
    bsz, s, _ = h.shape
    proj = h @ w_in + b_in
    q, k, v, g, glu_a, glu_b, gate_r, gate_c = jnp.split(proj, SPLIT_POINTS, axis=-1)

    q = rotary(q.reshape(bsz, s, RET_HEADS, RET_DK), cos, sin) * (RET_DK ** -0.5)
    k = rotary(k.reshape(bsz, s, RET_HEADS, RET_DK), cos, sin)
    v = v.reshape(bsz, s, RET_HEADS, RET_DV)
    r = retention_chunkwise(q, k, v)
    mu = jnp.mean(r, axis=-1, keepdims=True)
    var = jnp.mean(jnp.square(r - mu), axis=-1, keepdims=True)
    r = ((r - mu) * lax.rsqrt(var + LN_EPS)).reshape(bsz, s, V_W) * ret_gn_g.astype(jnp.float32)
    ret_out = (jax.nn.silu(g) * r.astype(h.dtype)) @ w_ret_o

    u = glu_a * jax.nn.sigmoid(glu_b)
    u = lax.conv_general_dilated(u, conv_k, window_strides=(1,), padding=[(CONV_WIDTH - 1, 0)],
                                 dimension_numbers=('NWC', 'WIO', 'NWC'),
                                 feature_group_count=CONV_CH) + conv_b
    u = jax.nn.silu(layer_norm(u, conv_ln_g, conv_ln_b))
    conv_out = u @ w_conv_o

    merged = jax.nn.sigmoid(gate_r) * ret_out + jax.nn.sigmoid(gate_c) * conv_out
    return merged @ w_out


def setup_inputs(seed: int = 0) -> dict:
    key = jax.random.key(seed)
    ks = jax.random.split(key, 24)
    beta = (8.0 * DEPTH) ** -0.25
    L = DEPTH

    def nrm(k, shape, scale):
        return jax.random.normal(k, shape, jnp.float32) * scale

    def gain(k, shape):
        return 1.0 + 0.02 * jax.random.normal(k, shape, jnp.float32)

    return {
        "x": jax.random.normal(ks[0], (BATCH, SEQ, D_MODEL), jnp.float32),
        "ffn1_w_gate": nrm(ks[1], (L, D_MODEL, D_FF), D_MODEL ** -0.5),
        "ffn1_w_up": nrm(ks[2], (L, D_MODEL, D_FF), D_MODEL ** -0.5),
        "ffn1_w_down": nrm(ks[3], (L, D_FF, D_MODEL), beta * D_FF ** -0.5),
        "ln1_g": gain(ks[4], (L, D_MODEL)),
        "ln1_b": nrm(ks[5], (L, D_MODEL), 0.02),
        "w_in": nrm(ks[6], (L, D_MODEL, IN_W), D_MODEL ** -0.5),
        "b_in": nrm(ks[7], (L, IN_W), 0.02),
        "ret_gn_g": gain(ks[8], (L, V_W)),
        "conv_k": nrm(ks[9], (L, CONV_WIDTH, 1, CONV_CH), CONV_WIDTH ** -0.5),
        "conv_b": nrm(ks[10], (L, CONV_CH), 0.02),
        "conv_ln_g": gain(ks[11], (L, CONV_CH)),
        "conv_ln_b": nrm(ks[12], (L, CONV_CH), 0.02),
        "w_ret_o": nrm(ks[13], (L, V_W, D_MODEL), beta * V_W ** -0.5),
        "w_conv_o": nrm(ks[14], (L, CONV_CH, D_MODEL), beta * CONV_CH ** -0.5),
        "w_out": nrm(ks[15], (L, D_MODEL, D_MODEL), beta * D_MODEL ** -0.5),
        "ln2_g": gain(ks[16], (L, D_MODEL)),
        "ln2_b": nrm(ks[17], (L, D_MODEL), 0.02),
        "ffn2_w_gate": nrm(ks[18], (L, D_MODEL, D_FF), D_MODEL ** -0.5),
        "ffn2_w_up": nrm(ks[19], (L, D_MODEL, D_FF), D_MODEL ** -0.5),
        "ffn2_w_down": nrm(ks[20], (L, D_FF, D_MODEL), beta * D_FF ** -0.5),
        "ln3_g": gain(ks[21], (L, D_MODEL)),
        "ln3_b": nrm(ks[22], (L, D_MODEL), 0.02),
    }


def reference(x, ffn1_w_gate, ffn1_w_up, ffn1_w_down, ln1_g, ln1_b, w_in, b_in, ret_gn_g,
              conv_k, conv_b, conv_ln_g, conv_ln_b, w_ret_o, w_conv_o, w_out, ln2_g, ln2_b,
              ffn2_w_gate, ffn2_w_up, ffn2_w_down, ln3_g, ln3_b):
    alpha = (2.0 * DEPTH) ** 0.25
    s = x.shape[1]
    half = RET_DK // 2
    freqs = ROPE_BASE ** (-jnp.arange(half, dtype=jnp.float32) / half)
    ang = jnp.arange(s, dtype=jnp.float32)[:, None] * freqs[None, :]
    cos = jnp.cos(ang)[:, None, :]
    sin = jnp.sin(ang)[:, None, :]

    for l in range(DEPTH):
        x = layer_norm(alpha * x + 0.5 * swiglu_ffn(x, ffn1_w_gate[l], ffn1_w_up[l], ffn1_w_down[l]),
                       ln1_g[l], ln1_b[l])
        m = hybrid_mixer(x, w_in[l], b_in[l], ret_gn_g[l], conv_k[l], conv_b[l], conv_ln_g[l],
                         conv_ln_b[l], w_ret_o[l], w_conv_o[l], w_out[l], cos, sin)
        x = layer_norm(alpha * x + m, ln2_g[l], ln2_b[l])
        x = layer_norm(alpha * x + 0.5 * swiglu_ffn(x, ffn2_w_gate[l], ffn2_w_up[l], ffn2_w_down[l]),
                       ln3_g[l], ln3_b[l])
    return x
```

```cpp
#include <hip/hip_runtime.h>
#include <hip/hip_cooperative_groups.h>
#include <cstdio>
#include <cstdint>
namespace cg = cooperative_groups;

#define LAS __attribute__((address_space(3)))
typedef unsigned short bf16_t;
typedef short bf16x8 __attribute__((ext_vector_type(8)));
typedef float f32x2 __attribute__((ext_vector_type(2)));
typedef float f32x4 __attribute__((ext_vector_type(4)));
typedef float f32x16 __attribute__((ext_vector_type(16)));
typedef unsigned u32x2 __attribute__((ext_vector_type(2)));
typedef unsigned u32x4 __attribute__((ext_vector_type(4)));
typedef short s16x4 __attribute__((ext_vector_type(4)));

constexpr int MTOK = 32768, DM = 1024, DFF = 2816, SEQ = 4096, NH = 8, DK = 128, DV = 256, INW = 10240;
constexpr float LN_EPS = 1e-5f;
constexpr float ALPHA = 1.189207115002721f;
constexpr float QSCALE = 0.08838834764831845f;

constexpr size_t MiB = 1u << 20;
constexpr size_t SZ_WGU = (size_t)2 * DFF * DM * 2, SZ_WD = (size_t)DM * DFF * 2, SZ_WIN = (size_t)INW * DM * 2;
constexpr size_t OFF_BIASP = 0;
constexpr size_t OFF_W1GU = 65536;
constexpr size_t OFF_W1D = OFF_W1GU + SZ_WGU;
constexpr size_t OFF_WIN = OFF_W1D + SZ_WD;
constexpr size_t OFF_WRO = OFF_WIN + SZ_WIN;
constexpr size_t OFF_WCO = OFF_WRO + (size_t)DM * 2048 * 2;
constexpr size_t OFF_WOUT = OFF_WCO + (size_t)DM * DM * 2;
constexpr size_t OFF_W2GU = OFF_WOUT + (size_t)DM * DM * 2;
constexpr size_t OFF_W2D = OFF_W2GU + SZ_WGU;
constexpr size_t OFF_COS = OFF_W2D + SZ_WD;
constexpr size_t OFF_SIN = OFF_COS + MiB;
constexpr size_t OFF_CVEC = OFF_SIN + MiB;
constexpr size_t CVEC_BYTES = (size_t)(2 * INW + 4 * DFF) * 4 + 128 * 256;
static_assert(OFF_CVEC + CVEC_BYTES <= 64 * MiB, "weights region");
constexpr size_t OFF_STATP1 = OFF_W1GU, OFF_STATP2 = OFF_W1GU + MiB, OFF_XBUF = OFF_W1GU + 2 * MiB;
constexpr size_t SLOT0 = 64 * MiB, SLOT = 64 * MiB;
#define SLOTP(i) (SLOT0 + (size_t)(i) * SLOT)
constexpr size_t WS_NEED = 512 * MiB;
constexpr int LDS_BYTES = 147456 + 256;

typedef __bf16 bf16x2v __attribute__((ext_vector_type(2)));
__device__ __forceinline__ unsigned cvt_pk_bf16(float lo, float hi) { const f32x2 v = {lo, hi}; return __builtin_bit_cast(unsigned, __builtin_convertvector(v, bf16x2v)); }
__device__ __forceinline__ float bf_lo(unsigned u) { return __uint_as_float(u << 16); }
__device__ __forceinline__ float bf_hi(unsigned u) { return __uint_as_float(u & 0xffff0000u); }
__device__ __forceinline__ float sigmoidf_(float x) { return __builtin_amdgcn_rcpf(1.0f + __expf(-x)); }
__device__ __forceinline__ float siluf_(float x) { return x * sigmoidf_(x); }
__device__ __forceinline__ u32x4 pack8(const f32x4 a, const f32x4 b) { u32x4 w; w.x = cvt_pk_bf16(a[0], a[1]); w.y = cvt_pk_bf16(a[2], a[3]); w.z = cvt_pk_bf16(b[0], b[1]); w.w = cvt_pk_bf16(b[2], b[3]); return w; }
__device__ __forceinline__ void unpack8(const u32x4 w, f32x4& a, f32x4& b) { a[0] = bf_lo(w.x); a[1] = bf_hi(w.x); a[2] = bf_lo(w.y); a[3] = bf_hi(w.y); b[0] = bf_lo(w.z); b[1] = bf_hi(w.z); b[2] = bf_lo(w.w); b[3] = bf_hi(w.w); }
__device__ __forceinline__ float log2gamma(int h) { return log2f(1.0f - exp2f(-5.0f - (float)h)); }
__device__ __forceinline__ float wave_sum(float v) {
#pragma unroll
    for (int o = 1; o < 64; o <<= 1) v += __shfl_xor(v, o);
    return v;
}

__device__ __forceinline__ void wave_sum2(float& a, float& b) {
#pragma unroll
    for (int o = 1; o < 64; o <<= 1) { const float ta = __shfl_xor(a, o), tb = __shfl_xor(b, o); a += ta; b += tb; }
}
namespace pg8 {
constexpr int BM = 256, BK = 64, HALF = 128, HTB = HALF * BK * 2, STAGE_BYTES = 8 * HTB, NXCD = 8, WGM = 4;
__host__ __device__ __forceinline__ int lds_byte(int r, int c) { const int st = (r >> 4) * 2 + (c >> 5), rr = r & 15, cc = c & 31, ob = rr * 64 + cc * 2; return st * 1024 + (ob ^ (((ob >> 9) & 1) << 5)); }
__host__ __device__ __forceinline__ void stage_rc(int b, int& R, int& C) { const int st = b / 1024, sb = b % 1024, swz = sb ^ (((sb >> 9) & 1) << 5); R = (st >> 1) * 16 + swz / 64; C = (st & 1) * 32 + (swz % 64) / 2; }
__host__ __device__ __forceinline__ int perm32(int rho) { const int n = rho >> 4, i = rho & 15; return 8 * (i >> 2) + 4 * n + (i & 3); }
struct Unit { int pm, pn; };
struct Gemm { const bf16_t* A; const bf16_t* Bt; int lda, ldb, K; };
struct StaticOrder {
    int nM, nN, nwg, G, c;
    __device__ void init(int M, int N, int G_, int c_) { nM = M / BM; nN = N / BM; nwg = nM * nN; G = G_; c = c_; }
    __device__ bool next(int i, Unit& u) const {
        const long L = (long)i * G + c; if (L >= nwg) return false;
        int wgid = (int)L; { const int q = nwg / NXCD, r = nwg % NXCD, xcd = wgid % NXCD, off = wgid / NXCD; wgid = (xcd < r ? xcd * (q + 1) : r * (q + 1) + (xcd - r) * q) + off; }
        const int nig = WGM * nN, gid = wgid / nig, fm = gid * WGM, gsz = (nM - fm) < WGM ? (nM - fm) : WGM;
        u.pm = fm + ((wgid % nig) % gsz); u.pn = (wgid % nig) / gsz; return true;
    }
};
typedef f32x4 Acc[2][2][4][2];

template <class Epi, int KMODE>
__device__ __forceinline__ void gemm_phase(LAS unsigned char* lds, const Gemm g, const StaticOrder& S, const Epi& E) {
    int tid = threadIdx.x; asm volatile("" : "+v"(tid));
    const int wid = __builtin_amdgcn_readfirstlane(tid >> 6), lane = tid & 63, wr = wid >> 2, wc = wid & 3, fr = lane & 15, fq = lane >> 4;
    const int nt = g.K / BK;
    unsigned voffA[2], voffB[2];
#pragma unroll
    for (int i = 0; i < 2; ++i) { int R, C; stage_rc(tid * 16 + i * 8192, R, C); const int Rb = Epi::PERM ? ((R & ~31) + perm32(R & 31)) : R;
        voffA[i] = (unsigned)(R * g.lda + C) * 2u; voffB[i] = (unsigned)(Rb * g.ldb + C) * 2u; }
    const size_t kstep = (size_t)(BK * 2);
    const size_t hstepA = (size_t)HALF * g.lda * 2, hstepB = (size_t)HALF * g.ldb * 2;
    const unsigned ldsw = (unsigned)wid * 1024u;
    const int aoff = lds_byte(wr * 64 + fr, fq * 8), boff = lds_byte(wc * 32 + fr, fq * 8);
#define TILE_A(pm) ((const char*)g.A + (KMODE ? ((size_t)(((pm) >> 4) * NH * SEQ + ((pm) & 15) * 256) * 512) : (size_t)(pm) * 2 * hstepA))
#define TILE_B(pn) ((const char*)g.Bt + (size_t)(pn) * 2 * hstepB)
#define KOFF_A(t) (KMODE ? ((size_t)((t) >> 2) * ((size_t)SEQ * 512) + (size_t)((t) & 3) * kstep) : (size_t)(t) * kstep)
#define PG8_SA(b, h) (((b) * 2 + (h)) * HTB)
#define PG8_SB(b, h) ((4 + (b) * 2 + (h)) * HTB)
#define PG8_STAGE(bufoff, gbase, voff) do { _Pragma("unroll") for (int _i = 0; _i < 2; ++_i) \
        __builtin_amdgcn_global_load_lds((const unsigned*)((const char*)(gbase) + (voff)[_i]), (LAS unsigned*)(lds + (bufoff) + ldsw + _i * 8192), 16, 0, 0); } while (0)
#define PG8_LDA(dst, b, h) do { _Pragma("unroll") for (int m = 0; m < 4; ++m) _Pragma("unroll") for (int k = 0; k < 2; ++k) dst[m][k] = *(const LAS bf16x8*)(lds + PG8_SA(b, h) + aoff + m * 2048 + k * 1024); } while (0)
#define PG8_LDB(dst, b, h) do { _Pragma("unroll") for (int n = 0; n < 2; ++n) _Pragma("unroll") for (int k = 0; k < 2; ++k) dst[n][k] = *(const LAS bf16x8*)(lds + PG8_SB(b, h) + boff + n * 2048 + k * 1024); } while (0)
#define PG8_MMA(ai, bj, At, Bt) do { __builtin_amdgcn_s_setprio(1); _Pragma("unroll") for (int m = 0; m < 4; ++m) _Pragma("unroll") for (int n = 0; n < 2; ++n) _Pragma("unroll") for (int k = 0; k < 2; ++k) \
        acc[ai][bj][m][n] = __builtin_amdgcn_mfma_f32_16x16x32_bf16(Bt[n][k], At[m][k], acc[ai][bj][m][n], 0, 0, 0); __builtin_amdgcn_s_setprio(0); } while (0)
#define PG8_WAIT_V(n) asm volatile("s_waitcnt vmcnt(" #n ")" ::: "memory")
#define PG8_WAIT_L(n) asm volatile("s_waitcnt lgkmcnt(" #n ")" ::: "memory")
#define PG8_BAR __builtin_amdgcn_s_barrier()
#define PG8_SCHED __builtin_amdgcn_sched_barrier(0)
    Unit cur, nxt; int ui = 0;
    if (!S.next(0, cur)) return;
    Acc acc;
#pragma unroll
    for (int a = 0; a < 2; ++a)
#pragma unroll
        for (int b = 0; b < 2; ++b)
#pragma unroll
            for (int m = 0; m < 4; ++m)
#pragma unroll
                for (int n = 0; n < 2; ++n) acc[a][b][m][n] = (f32x4){0.f, 0.f, 0.f, 0.f};
    bf16x8 At[4][2], B0[2][2], B1[2][2];
    const char* cA = TILE_A(cur.pm); const char* cB = TILE_B(cur.pn);
    {
        PG8_STAGE(PG8_SB(0, 0), cB, voffB); PG8_STAGE(PG8_SB(0, 1), cB + hstepB, voffB); PG8_STAGE(PG8_SA(0, 0), cA, voffA); PG8_STAGE(PG8_SA(0, 1), cA + hstepA, voffA);
        if (wr == 1) PG8_BAR;
        PG8_WAIT_V(2); PG8_BAR;
        PG8_STAGE(PG8_SB(1, 0), cB + kstep, voffB); PG8_STAGE(PG8_SA(1, 0), cA + KOFF_A(1), voffA); PG8_STAGE(PG8_SB(1, 1), cB + hstepB + kstep, voffB);
        PG8_WAIT_V(6); PG8_BAR;
    }
    for (;;) {
        const bool has_next = S.next(ui + 1, nxt);
        int tid_p = tid; asm volatile("" : "+v"(tid_p));
        const f32x4 pre = E.pre_load(cur, tid_p);
        const char* nA = has_next ? TILE_A(nxt.pm) : cA; const char* nB = has_next ? TILE_B(nxt.pn) : cB;
        for (int t = 0; t < nt; t += 2) {
            const bool last = (t == nt - 2);
            const char* a1 = cA + KOFF_A(t + 1);
            const char* a2 = last ? nA : cA + KOFF_A(t + 2); const char* b2 = last ? nB : cB + (size_t)(t + 2) * kstep;
            const char* a3 = last ? nA + KOFF_A(1) : cA + KOFF_A(t + 3); const char* b3 = b2 + kstep;
            PG8_LDB(B0, 0, 0); PG8_LDB(B1, 0, 1); PG8_SCHED; PG8_LDA(At, 0, 0); PG8_STAGE(PG8_SA(1, 1), a1 + hstepA, voffA);
            PG8_WAIT_V(8); PG8_WAIT_L(0); PG8_BAR; PG8_MMA(0, 0, At, B0); PG8_MMA(0, 1, At, B1); PG8_BAR; PG8_SCHED;
            PG8_LDA(At, 0, 1); PG8_STAGE(PG8_SB(0, 0), b2, voffB); PG8_STAGE(PG8_SB(0, 1), b2 + hstepB, voffB); PG8_STAGE(PG8_SA(0, 0), a2, voffA);
            PG8_WAIT_V(8); PG8_WAIT_L(0); PG8_BAR; PG8_MMA(1, 0, At, B0); PG8_MMA(1, 1, At, B1); PG8_BAR; PG8_SCHED;
            PG8_LDB(B0, 1, 0); PG8_LDB(B1, 1, 1); PG8_SCHED; PG8_LDA(At, 1, 0); PG8_STAGE(PG8_SA(0, 1), a2 + hstepA, voffA);
            PG8_WAIT_V(8); PG8_WAIT_L(0); PG8_BAR; PG8_MMA(0, 0, At, B0); PG8_MMA(0, 1, At, B1); PG8_BAR; PG8_SCHED;
            PG8_LDA(At, 1, 1); PG8_STAGE(PG8_SB(1, 0), b3, voffB); PG8_STAGE(PG8_SB(1, 1), b3 + hstepB, voffB); PG8_STAGE(PG8_SA(1, 0), a3, voffA);
            PG8_WAIT_V(8); PG8_WAIT_L(0); PG8_BAR; PG8_MMA(1, 0, At, B0); PG8_MMA(1, 1, At, B1); PG8_BAR; PG8_SCHED;
        }
        if (wr == 0) PG8_BAR;
        { int fr_e = fr, fq_e = fq, tid_e = tid; asm volatile("" : "+v"(fr_e), "+v"(fq_e), "+v"(tid_e));
          E(acc, cur, wr, wc, fr_e, fq_e, lds, tid_e, pre); }
        if (!has_next) break;
#pragma unroll
        for (int a = 0; a < 2; ++a)
#pragma unroll
            for (int b = 0; b < 2; ++b)
#pragma unroll
                for (int m = 0; m < 4; ++m)
#pragma unroll
                    for (int n = 0; n < 2; ++n) acc[a][b][m][n] = (f32x4){0.f, 0.f, 0.f, 0.f};
        cur = nxt; cA = nA; cB = nB; ++ui;
        if (wr == 1) PG8_BAR;
    }
    PG8_WAIT_V(0);
    PG8_BAR;
#undef TILE_A
#undef TILE_B
#undef KOFF_A
#undef PG8_SA
#undef PG8_SB
#undef PG8_STAGE
#undef PG8_LDA
#undef PG8_LDB
#undef PG8_MMA
#undef PG8_WAIT_V
#undef PG8_WAIT_L
#undef PG8_BAR
#undef PG8_SCHED
}

#define EPI_ARGS const Acc& acc, const Unit& u, int wr, int wc, int fr, int fq, LAS unsigned char* lds, int tid, const f32x4 pre
#define EPI_NOPRE __device__ __forceinline__ f32x4 pre_load(const Unit&, int) const { return (f32x4){0.f, 0.f, 0.f, 0.f}; }
constexpr int LDS_TAB = 131072;
#define EPI_BARRIER() do { asm volatile("s_waitcnt lgkmcnt(0)" ::: "memory"); __builtin_amdgcn_s_barrier(); asm volatile("" ::: "memory"); } while (0)
__device__ __forceinline__ f32x4 ln_pre(const f32x2* statp, int row_base, int tid) { return *(const f32x4*)(statp + (size_t)(row_base + (tid >> 1)) * 4 + 2 * (tid & 1)); }
__device__ __forceinline__ void ln_table(LAS unsigned char* lds, const f32x4 v, int tid) {
    LAS f32x2* S = (LAS f32x2*)(lds + LDS_TAB);
    const int r = tid >> 1, hf = tid & 1;
    float s = v[0] + v[2], q = v[1] + v[3];
    s += __shfl_xor(s, 1); q += __shfl_xor(q, 1);
    const float mean = s * (1.f / DM), var = fmaxf(q * (1.f / DM) - mean * mean, 0.f);
    if (hf == 0) S[r] = (f32x2){mean, 1.0f / sqrtf(var + LN_EPS)};
    EPI_BARRIER();
}
#define LNX(a, c1v, c2v) (((a) - (c1v) * mu) * rs + (c2v))
template <bool LN> struct EpiGU { static constexpr bool PERM = true; bf16_t* H; const f32x2* statp; const float* c1; const float* c2;
    __device__ __forceinline__ f32x4 pre_load(const Unit& u, int tid) const { return LN ? ln_pre(statp, u.pm * 256, tid) : (f32x4){0.f, 0.f, 0.f, 0.f}; }
    __device__ __forceinline__ void operator()(EPI_ARGS) const {
        const int i0 = wc * 32 + fq * 8, c0 = u.pn * 128 + i0;
        f32x4 g1a, g1b, u1a, u1b, g2a, g2b, u2a, u2b;
        if (LN) { ln_table(lds, pre, tid); const float* p1 = c1 + u.pn * 256 + i0; const float* p2 = c2 + u.pn * 256 + i0;
            g1a = *(const f32x4*)p1; g1b = *(const f32x4*)(p1 + 4); u1a = *(const f32x4*)(p1 + 128); u1b = *(const f32x4*)(p1 + 132);
            g2a = *(const f32x4*)p2; g2b = *(const f32x4*)(p2 + 4); u2a = *(const f32x4*)(p2 + 128); u2b = *(const f32x4*)(p2 + 132); }
        const LAS f32x2* S = (const LAS f32x2*)(lds + LDS_TAB);
#pragma unroll
        for (int ai = 0; ai < 2; ++ai)
#pragma unroll
            for (int m = 0; m < 4; ++m) { const int rl = ai * 128 + wr * 64 + m * 16 + fr, row = u.pm * 256 + rl;
                f32x4 ga = acc[ai][0][m][0], gb = acc[ai][0][m][1], ua = acc[ai][1][m][0], ub = acc[ai][1][m][1];
                if (LN) { const f32x2 st = S[rl]; const float mu = st[0], rs = st[1]; ga = LNX(ga, g1a, g2a); gb = LNX(gb, g1b, g2b); ua = LNX(ua, u1a, u2a); ub = LNX(ub, u1b, u2b); }
                f32x4 h0, h1;
#pragma unroll
                for (int j = 0; j < 4; ++j) { h0[j] = siluf_(ga[j]) * ua[j]; h1[j] = siluf_(gb[j]) * ub[j]; }
                *(u32x4*)(H + (size_t)row * DFF + c0) = pack8(h0, h1); }
    } };
template <int MODE> struct EpiResLn { static constexpr bool PERM = true; const float* X; bf16_t* Tb; f32x2* statp; const f32x2* statp_prev; const float* g; const float* b; float scale;
    __device__ __forceinline__ f32x4 pre_load(const Unit& u, int tid) const { return MODE == 1 ? ln_pre(statp_prev, u.pm * 256, tid) : (f32x4){0.f, 0.f, 0.f, 0.f}; }
    __device__ __forceinline__ void operator()(EPI_ARGS) const {
        if (MODE == 1) ln_table(lds, pre, tid);
        const LAS f32x2* S = (const LAS f32x2*)(lds + LDS_TAB); LAS f32x2* P = (LAS f32x2*)(lds + LDS_TAB + 2048);
        const int cb = u.pn * 256 + wc * 32 + fq * 8;
        f32x4 gg[2][2], bb[2][2];
        if (MODE == 1) {
#pragma unroll
            for (int bj = 0; bj < 2; ++bj)
#pragma unroll
                for (int n = 0; n < 2; ++n) { gg[bj][n] = *(const f32x4*)(g + cb + bj * 128 + n * 4); bb[bj][n] = *(const f32x4*)(b + cb + bj * 128 + n * 4); } }
#pragma unroll
        for (int ai = 0; ai < 2; ++ai) { f32x4 src[4][2][2]; u32x2 srb[4][2][2];
#pragma unroll
                for (int m = 0; m < 4; ++m)
#pragma unroll
                    for (int bj = 0; bj < 2; ++bj)
#pragma unroll
                        for (int n = 0; n < 2; ++n) { const size_t o = (size_t)(u.pm * 256 + ai * 128 + wr * 64 + m * 16 + fr) * DM + cb + bj * 128 + n * 4;
                            if (MODE == 0) src[m][bj][n] = *(const f32x4*)(X + o); else srb[m][bj][n] = *(const u32x2*)(Tb + o); }
                asm volatile("" ::: "memory");
#pragma unroll
                for (int m = 0; m < 4; ++m) { const int rl = ai * 128 + wr * 64 + m * 16 + fr, row = u.pm * 256 + rl; float mu = 0.f, rs = 0.f;
                    if (MODE == 1) { const f32x2 st = S[rl]; mu = st[0]; rs = st[1]; }
                    float sm = 0.f, q = 0.f;
#pragma unroll
                    for (int bj = 0; bj < 2; ++bj)
#pragma unroll
                        for (int n = 0; n < 2; ++n) { const size_t o = (size_t)row * DM + cb + bj * 128 + n * 4; f32x4 res;
                            if (MODE == 0) res = src[m][bj][n];
                            else { const u32x2 w = srb[m][bj][n]; const f32x4 t = {bf_lo(w.x), bf_hi(w.x), bf_lo(w.y), bf_hi(w.y)}; res = (t - mu) * rs * gg[bj][n] + bb[bj][n]; }
                            const f32x4 v = res * ALPHA + acc[ai][bj][m][n] * scale;
                            { u32x2 w; w.x = cvt_pk_bf16(v[0], v[1]); w.y = cvt_pk_bf16(v[2], v[3]); *(u32x2*)(Tb + o) = w; }
                            sm += (v[0] + v[1]) + (v[2] + v[3]); q += (v[0] * v[0] + v[1] * v[1]) + (v[2] * v[2] + v[3] * v[3]); }
                    sm += __shfl_xor(sm, 16); q += __shfl_xor(q, 16); sm += __shfl_xor(sm, 32); q += __shfl_xor(q, 32); if (fq == 0) P[rl * 4 + wc] = (f32x2){sm, q}; }
                asm volatile("" ::: "memory"); }
        EPI_BARRIER();
        if (tid < 256) { const f32x2 a0 = P[tid * 4], a1 = P[tid * 4 + 1], a2 = P[tid * 4 + 2], a3 = P[tid * 4 + 3]; statp[(size_t)(u.pm * 256 + tid) * 4 + u.pn] = (f32x2){(a0[0] + a1[0]) + (a2[0] + a3[0]), (a0[1] + a1[1]) + (a2[1] + a3[1])}; }
    } };
struct EpiQK { static constexpr bool PERM = true; bf16_t* Q; bf16_t* Kk; const f32x2* statp; const float* c1; const float* c2;
    __device__ __forceinline__ f32x4 pre_load(const Unit& u, int tid) const { return ln_pre(statp, u.pm * 256, tid); }
    __device__ __forceinline__ void operator()(EPI_ARGS) const {
        ln_table(lds, pre, tid); const LAS f32x2* S = (const LAS f32x2*)(lds + LDS_TAB);
        const bool isK = u.pn >= 4; const int t4 = u.pn & 3; bf16_t* dst = isK ? Kk : Q; const float QS = QSCALE;
        const int i0 = wc * 32 + fq * 8, head = 2 * t4 + (i0 >> 6), dlo = i0 & 63; const float lgk = log2gamma(head);
        const float* p1 = c1 + u.pn * 256 + i0; const float* p2 = c2 + u.pn * 256 + i0;
        const f32x4 k1a = *(const f32x4*)(p1), k1b = *(const f32x4*)(p1 + 4), k2a = *(const f32x4*)(p1 + 128), k2b = *(const f32x4*)(p1 + 132);
        const f32x4 b1a = *(const f32x4*)(p2), b1b = *(const f32x4*)(p2 + 4), b2a = *(const f32x4*)(p2 + 128), b2b = *(const f32x4*)(p2 + 132);
        f32x4 fa, fb;
#pragma unroll
        for (int j = 0; j < 4; ++j) { fa[j] = exp2f(-(float)(dlo + j) * 0.20762050593046014f) * 0.15915494309189535f; fb[j] = exp2f(-(float)(dlo + 4 + j) * 0.20762050593046014f) * 0.15915494309189535f; }
#pragma unroll
        for (int ai = 0; ai < 2; ++ai)
#pragma unroll
            for (int m = 0; m < 4; ++m) { const int rl = ai * 128 + wr * 64 + m * 16 + fr, row = u.pm * 256 + rl; const int s = row & (SEQ - 1), b = row >> 12;
                const f32x2 st = S[rl]; const float mu = st[0], rs = st[1]; const float sf = (float)s;
                f32x4 ca, cb, sa, sb;
#pragma unroll
                for (int j = 0; j < 4; ++j) { const float ra = __builtin_amdgcn_fractf(sf * fa[j]), rb = __builtin_amdgcn_fractf(sf * fb[j]);
                    ca[j] = __builtin_amdgcn_cosf(ra); sa[j] = __builtin_amdgcn_sinf(ra); cb[j] = __builtin_amdgcn_cosf(rb); sb[j] = __builtin_amdgcn_sinf(rb); }
                const f32x4 x1a = LNX(acc[ai][0][m][0], k1a, b1a), x1b = LNX(acc[ai][0][m][1], k1b, b1b), x2a = LNX(acc[ai][1][m][0], k2a, b2a), x2b = LNX(acc[ai][1][m][1], k2b, b2b);
                const float sc = isK ? exp2f((float)(127 - (s & 127)) * lgk) : QS;
                const f32x4 o1a = (x1a * ca - x2a * sa) * sc, o1b = (x1b * cb - x2b * sb) * sc, o2a = (x2a * ca + x1a * sa) * sc, o2b = (x2b * cb + x1b * sb) * sc;
                bf16_t* base = dst + ((size_t)((b * NH + head) * SEQ + s)) * DK + dlo;
                *(u32x4*)(base) = pack8(o1a, o1b); *(u32x4*)(base + 64) = pack8(o2a, o2b); }
    } };
struct EpiVT { static constexpr bool PERM = true; bf16_t* VT; const f32x2* statp; const float* c1; const float* c2;
    __device__ __forceinline__ f32x4 pre_load(const Unit& u, int tid) const { return ln_pre(statp, u.pn * 256, tid); }
    __device__ __forceinline__ void operator()(EPI_ARGS) const {
        ln_table(lds, pre, tid); const LAS f32x4* S4 = (const LAS f32x4*)(lds + LDS_TAB);
        float kk[2][4], bi[2][4];
#pragma unroll
        for (int ai = 0; ai < 2; ++ai)
#pragma unroll
            for (int m = 0; m < 4; ++m) { const int r = u.pm * 256 + ai * 128 + wr * 64 + m * 16 + fr; kk[ai][m] = c1[r]; bi[ai][m] = c2[r]; }
        asm volatile("" ::: "memory");
#pragma unroll
        for (int bj = 0; bj < 2; ++bj) { const int tl = bj * 128 + wc * 32 + fq * 8, tok0 = u.pn * 256 + tl; const int s0 = tok0 & (SEQ - 1), b = tok0 >> 12;
            const f32x4 t01 = S4[tl / 2], t23 = S4[tl / 2 + 1], t45 = S4[tl / 2 + 2], t67 = S4[tl / 2 + 3];
            const f32x4 mua = {t01[0], t01[2], t23[0], t23[2]}, rsa = {t01[1], t01[3], t23[1], t23[3]}, mub = {t45[0], t45[2], t67[0], t67[2]}, rsb = {t45[1], t45[3], t67[1], t67[3]};
            const int nch = s0 >> 7, j0 = s0 & 127, ks = j0 >> 4, lhh = (j0 >> 3) & 1;
#pragma unroll
            for (int ai = 0; ai < 2; ++ai)
#pragma unroll
                for (int m = 0; m < 4; ++m) { const int r = u.pm * 256 + ai * 128 + wr * 64 + m * 16 + fr; const float k1 = kk[ai][m], bv = bi[ai][m]; const int e = r & 255;
                    *(u32x4*)(VT + ((((size_t)((b * NH + u.pm) * 32 + nch) * 8 + (e >> 5)) * 8 + ks) * 64 + lhh * 32 + (e & 31)) * 8) = pack8((acc[ai][bj][m][0] - mua * k1) * rsa + bv, (acc[ai][bj][m][1] - mub * k1) * rsb + bv); } }
    } };
struct EpiG { static constexpr bool PERM = true; bf16_t* RN; const f32x2* statp; const float* c1; const float* c2;
    __device__ __forceinline__ f32x4 pre_load(const Unit& u, int tid) const { return ln_pre(statp, u.pm * 256, tid); }
    __device__ __forceinline__ void operator()(EPI_ARGS) const {
        ln_table(lds, pre, tid); const LAS f32x2* S = (const LAS f32x2*)(lds + LDS_TAB);
#pragma unroll
        for (int bj = 0; bj < 2; ++bj) { const int e0 = bj * 128 + wc * 32 + fq * 8; const float* p1 = c1 + u.pn * 256 + e0; const float* p2 = c2 + u.pn * 256 + e0;
            const f32x4 ka = *(const f32x4*)p1, kb = *(const f32x4*)(p1 + 4), ba = *(const f32x4*)p2, bb = *(const f32x4*)(p2 + 4);
            u32x4 rn[2][4];
#pragma unroll
            for (int ai = 0; ai < 2; ++ai)
#pragma unroll
                for (int m = 0; m < 4; ++m) { const int row = u.pm * 256 + ai * 128 + wr * 64 + m * 16 + fr; rn[ai][m] = *(const u32x4*)(RN + ((size_t)(((row >> 12) * NH + u.pn) * SEQ + (row & (SEQ - 1)))) * DV + e0); }
            asm volatile("" ::: "memory");
#pragma unroll
            for (int ai = 0; ai < 2; ++ai)
#pragma unroll
                for (int m = 0; m < 4; ++m) { const int rl = ai * 128 + wr * 64 + m * 16 + fr, row = u.pm * 256 + rl; const int s = row & (SEQ - 1), b = row >> 12;
                    const f32x2 st = S[rl]; const float mu = st[0], rs = st[1];
                    bf16_t* p = RN + ((size_t)((b * NH + u.pn) * SEQ + s)) * DV + e0; f32x4 ra, rb; unpack8(rn[ai][m], ra, rb);
                    f32x4 ga = LNX(acc[ai][bj][m][0], ka, ba), gb = LNX(acc[ai][bj][m][1], kb, bb);
#pragma unroll
                    for (int j = 0; j < 4; ++j) { ga[j] = siluf_(ga[j]) * ra[j]; gb[j] = siluf_(gb[j]) * rb[j]; }
                    *(u32x4*)p = pack8(ga, gb); }
            asm volatile("" ::: "memory"); }
    } };
struct EpiU { static constexpr bool PERM = true; bf16_t* U; const f32x2* statp; const float* c1; const float* c2;
    __device__ __forceinline__ f32x4 pre_load(const Unit& u, int tid) const { return ln_pre(statp, u.pm * 256, tid); }
    __device__ __forceinline__ void operator()(EPI_ARGS) const {
        ln_table(lds, pre, tid); const LAS f32x2* S = (const LAS f32x2*)(lds + LDS_TAB);
        const int i0 = wc * 32 + fq * 8; const float* p1 = c1 + u.pn * 256 + i0; const float* p2 = c2 + u.pn * 256 + i0;
        const f32x4 k1a = *(const f32x4*)(p1), k1b = *(const f32x4*)(p1 + 4), k2a = *(const f32x4*)(p1 + 128), k2b = *(const f32x4*)(p1 + 132);
        const f32x4 b1a = *(const f32x4*)(p2), b1b = *(const f32x4*)(p2 + 4), b2a = *(const f32x4*)(p2 + 128), b2b = *(const f32x4*)(p2 + 132);
#pragma unroll
        for (int ai = 0; ai < 2; ++ai)
#pragma unroll
            for (int m = 0; m < 4; ++m) { const int rl = ai * 128 + wr * 64 + m * 16 + fr, row = u.pm * 256 + rl; const f32x2 st = S[rl]; const float mu = st[0], rs = st[1];
                f32x4 xa = LNX(acc[ai][0][m][0], k1a, b1a), xb = LNX(acc[ai][0][m][1], k1b, b1b); const f32x4 ya = LNX(acc[ai][1][m][0], k2a, b2a), yb = LNX(acc[ai][1][m][1], k2b, b2b);
#pragma unroll
                for (int j = 0; j < 4; ++j) { xa[j] *= sigmoidf_(ya[j]); xb[j] *= sigmoidf_(yb[j]); }
                *(u32x4*)(U + (size_t)row * DM + u.pn * 128 + i0) = pack8(xa, xb); }
    } };
struct EpiGates { static constexpr bool PERM = true; bf16_t* GR; bf16_t* GC; const f32x2* statp; const float* c1; const float* c2;
    __device__ __forceinline__ f32x4 pre_load(const Unit& u, int tid) const { return ln_pre(statp, u.pm * 256, tid); }
    __device__ __forceinline__ void operator()(EPI_ARGS) const {
        ln_table(lds, pre, tid); const LAS f32x2* S = (const LAS f32x2*)(lds + LDS_TAB);
        bf16_t* dst = u.pn < 4 ? GR : GC;
        f32x4 kv[2][2], bv[2][2];
#pragma unroll
        for (int bj = 0; bj < 2; ++bj) { const int c0 = u.pn * 256 + bj * 128 + wc * 32 + fq * 8; kv[bj][0] = *(const f32x4*)(c1 + c0); kv[bj][1] = *(const f32x4*)(c1 + c0 + 4); bv[bj][0] = *(const f32x4*)(c2 + c0); bv[bj][1] = *(const f32x4*)(c2 + c0 + 4); }
        asm volatile("" ::: "memory");
#pragma unroll
        for (int bj = 0; bj < 2; ++bj) { const int c0 = u.pn * 256 + bj * 128 + wc * 32 + fq * 8;
#pragma unroll
            for (int ai = 0; ai < 2; ++ai)
#pragma unroll
                for (int m = 0; m < 4; ++m) { const int rl = ai * 128 + wr * 64 + m * 16 + fr, row = u.pm * 256 + rl; const f32x2 st = S[rl]; const float mu = st[0], rs = st[1];
                    f32x4 ga = LNX(acc[ai][bj][m][0], kv[bj][0], bv[bj][0]), gb = LNX(acc[ai][bj][m][1], kv[bj][1], bv[bj][1]);
#pragma unroll
                    for (int j = 0; j < 4; ++j) { ga[j] = sigmoidf_(ga[j]); gb[j] = sigmoidf_(gb[j]); }
                    *(u32x4*)(dst + (size_t)row * DM + (c0 & 1023)) = pack8(ga, gb); } }
    } };
struct EpiRO { static constexpr bool PERM = true; const bf16_t* GR; bf16_t* T1; EPI_NOPRE
    __device__ __forceinline__ void operator()(EPI_ARGS) const {
#pragma unroll
        for (int ai = 0; ai < 2; ++ai) { u32x4 gr[4][2];
#pragma unroll
            for (int m = 0; m < 4; ++m)
#pragma unroll
                for (int bj = 0; bj < 2; ++bj) gr[m][bj] = *(const u32x4*)(GR + (size_t)(u.pm * 256 + ai * 128 + wr * 64 + m * 16 + fr) * DM + u.pn * 256 + bj * 128 + wc * 32 + fq * 8);
            asm volatile("" ::: "memory");
#pragma unroll
            for (int m = 0; m < 4; ++m)
#pragma unroll
                for (int bj = 0; bj < 2; ++bj) { const size_t o = (size_t)(u.pm * 256 + ai * 128 + wr * 64 + m * 16 + fr) * DM + u.pn * 256 + bj * 128 + wc * 32 + fq * 8; f32x4 ga, gb; unpack8(gr[m][bj], ga, gb);
                    *(u32x4*)(T1 + o) = pack8(ga * acc[ai][bj][m][0], gb * acc[ai][bj][m][1]); }
            asm volatile("" ::: "memory"); }
    } };
struct EpiCO { static constexpr bool PERM = true; const bf16_t* GC; const bf16_t* T1; bf16_t* MG; EPI_NOPRE
    __device__ __forceinline__ void operator()(EPI_ARGS) const {
#pragma unroll
        for (int ai = 0; ai < 2; ++ai) { u32x4 gc[4][2], t1[4][2];
#pragma unroll
            for (int m = 0; m < 4; ++m)
#pragma unroll
                for (int bj = 0; bj < 2; ++bj) { const size_t o = (size_t)(u.pm * 256 + ai * 128 + wr * 64 + m * 16 + fr) * DM + u.pn * 256 + bj * 128 + wc * 32 + fq * 8;
                    gc[m][bj] = *(const u32x4*)(GC + o); t1[m][bj] = *(const u32x4*)(T1 + o); }
            asm volatile("" ::: "memory");
#pragma unroll
            for (int m = 0; m < 4; ++m)
#pragma unroll
                for (int bj = 0; bj < 2; ++bj) { const size_t o = (size_t)(u.pm * 256 + ai * 128 + wr * 64 + m * 16 + fr) * DM + u.pn * 256 + bj * 128 + wc * 32 + fq * 8; f32x4 ga, gb, ta, tb; unpack8(gc[m][bj], ga, gb); unpack8(t1[m][bj], ta, tb);
                    *(u32x4*)(MG + o) = pack8(ta + ga * acc[ai][bj][m][0], tb + gb * acc[ai][bj][m][1]); }
            asm volatile("" ::: "memory"); }
    } };
struct EpiFinalLn { static constexpr bool PERM = true; float* Out; const bf16_t* Tsrc; const f32x2* statp_prev; const float* g; const float* b; float scale; unsigned long long* xbuf; unsigned* cnt; const float* g3; const float* b3;
    __device__ __forceinline__ f32x4 pre_load(const Unit& u, int tid) const { return ln_pre(statp_prev, u.pm * 256, tid); }
    __device__ __forceinline__ void operator()(EPI_ARGS) const {
        Acc& a = const_cast<Acc&>(acc);
        ln_table(lds, pre, tid);
        LAS f32x2* S = (LAS f32x2*)(lds + LDS_TAB); LAS f32x2* P = (LAS f32x2*)(lds + LDS_TAB + 2048);
        const int cb = u.pn * 256 + wc * 32 + fq * 8;
        { f32x4 gg[2][2], bb[2][2];
#pragma unroll
          for (int bj = 0; bj < 2; ++bj)
#pragma unroll
            for (int n = 0; n < 2; ++n) { gg[bj][n] = *(const f32x4*)(g + cb + bj * 128 + n * 4); bb[bj][n] = *(const f32x4*)(b + cb + bj * 128 + n * 4); }
#pragma unroll
          for (int ai = 0; ai < 2; ++ai) { u32x2 srb[4][2][2];
#pragma unroll
                for (int m = 0; m < 4; ++m)
#pragma unroll
                    for (int bj = 0; bj < 2; ++bj)
#pragma unroll
                        for (int n = 0; n < 2; ++n) srb[m][bj][n] = *(const u32x2*)(Tsrc + (size_t)(u.pm * 256 + ai * 128 + wr * 64 + m * 16 + fr) * DM + cb + bj * 128 + n * 4);
                asm volatile("" ::: "memory");
#pragma unroll
                for (int m = 0; m < 4; ++m) { const int rl = ai * 128 + wr * 64 + m * 16 + fr; const f32x2 st = S[rl]; const float mu = st[0], rs = st[1];
                    float sm = 0.f, q = 0.f;
#pragma unroll
                    for (int bj = 0; bj < 2; ++bj)
#pragma unroll
                        for (int n = 0; n < 2; ++n) { const u32x2 w = srb[m][bj][n]; const f32x4 t = {bf_lo(w.x), bf_hi(w.x), bf_lo(w.y), bf_hi(w.y)};
                            const f32x4 res = (t - mu) * rs * gg[bj][n] + bb[bj][n]; const f32x4 v = res * ALPHA + a[ai][bj][m][n] * scale; a[ai][bj][m][n] = v;
                            sm += (v[0] + v[1]) + (v[2] + v[3]); q += (v[0] * v[0] + v[1] * v[1]) + (v[2] * v[2] + v[3] * v[3]); }
                    sm += __shfl_xor(sm, 16); q += __shfl_xor(q, 16); sm += __shfl_xor(sm, 32); q += __shfl_xor(q, 32); if (fq == 0) P[rl * 4 + wc] = (f32x2){sm, q}; }
                asm volatile("" ::: "memory"); } }
        EPI_BARRIER();
        if (tid < 256) { const f32x2 a0 = P[tid * 4], a1 = P[tid * 4 + 1], a2 = P[tid * 4 + 2], a3 = P[tid * 4 + 3]; const float ssum = (a0[0] + a1[0]) + (a2[0] + a3[0]), qsum = (a0[1] + a1[1]) + (a2[1] + a3[1]);
            __hip_atomic_store(xbuf + (size_t)(u.pm * 256 + tid) * 4 + u.pn, ((unsigned long long)__float_as_uint(qsum) << 32) | __float_as_uint(ssum), __ATOMIC_RELAXED, __HIP_MEMORY_SCOPE_AGENT); }
        asm volatile("s_waitcnt vmcnt(0)" ::: "memory");
        if (tid < 256 && (tid & 63) == 0) __hip_atomic_fetch_add(cnt + 64 * u.pm, 1u, __ATOMIC_RELAXED, __HIP_MEMORY_SCOPE_AGENT);
        if (tid < 64) { unsigned sp = 0;
            while ((unsigned)__builtin_amdgcn_readfirstlane(__hip_atomic_load(cnt + 64 * u.pm, __ATOMIC_RELAXED, __HIP_MEMORY_SCOPE_AGENT)) < 16u) { __builtin_amdgcn_s_sleep(1); if (++sp > (1u << 20)) break; }
            __builtin_amdgcn_fence(__ATOMIC_ACQUIRE, "agent"); asm volatile("s_waitcnt vmcnt(0)" ::: "memory"); }
        EPI_BARRIER();
        { const int r = tid >> 1, hf = tid & 1; const unsigned long long* sl = xbuf + (size_t)(u.pm * 256 + r) * 4 + 2 * hf;
          const unsigned long long w0 = __hip_atomic_load(sl, __ATOMIC_RELAXED, __HIP_MEMORY_SCOPE_AGENT), w1 = __hip_atomic_load(sl + 1, __ATOMIC_RELAXED, __HIP_MEMORY_SCOPE_AGENT);
          float sm = __uint_as_float((unsigned)w0) + __uint_as_float((unsigned)w1), q = __uint_as_float((unsigned)(w0 >> 32)) + __uint_as_float((unsigned)(w1 >> 32));
          sm += __shfl_xor(sm, 1); q += __shfl_xor(q, 1);
          const float mean = sm * (1.f / DM), var = fmaxf(q * (1.f / DM) - mean * mean, 0.f);
          if (hf == 0) S[r] = (f32x2){mean, 1.0f / sqrtf(var + LN_EPS)}; }
        EPI_BARRIER();
        { f32x4 g4[2][2], b4[2][2];
#pragma unroll
          for (int bj = 0; bj < 2; ++bj)
#pragma unroll
            for (int n = 0; n < 2; ++n) { g4[bj][n] = *(const f32x4*)(g3 + cb + bj * 128 + n * 4); b4[bj][n] = *(const f32x4*)(b3 + cb + bj * 128 + n * 4); }
          asm volatile("" ::: "memory");
#pragma unroll
          for (int ai = 0; ai < 2; ++ai)
#pragma unroll
            for (int m = 0; m < 4; ++m) { const int rl = ai * 128 + wr * 64 + m * 16 + fr; const f32x2 st = S[rl]; const float mu = st[0], rs = st[1];
#pragma unroll
                for (int bj = 0; bj < 2; ++bj)
#pragma unroll
                    for (int n = 0; n < 2; ++n) *(f32x4*)(Out + (size_t)(u.pm * 256 + rl) * DM + cb + bj * 128 + n * 4) = (a[ai][bj][m][n] - mu) * rs * g4[bj][n] + b4[bj][n]; } }
    } };
struct EpiGUG { static constexpr bool PERM = true; EpiG eg; EpiU eu; EpiGates et;
    __device__ __forceinline__ f32x4 pre_load(const Unit& u, int tid) const { return ln_pre(eg.statp, u.pm * 256, tid); }
    __device__ __forceinline__ void operator()(EPI_ARGS) const {
        Unit v = u;
        if (u.pn < 8) eg(acc, v, wr, wc, fr, fq, lds, tid, pre);
        else if (u.pn < 16) { v.pn = u.pn - 8; eu(acc, v, wr, wc, fr, fq, lds, tid, pre); }
        else { v.pn = u.pn - 16; et(acc, v, wr, wc, fr, fq, lds, tid, pre); }
    } };
}

#ifndef REP_P0
#define REP_P0 1
#endif
#ifndef REP_LN
#define REP_LN 1
#endif
#ifndef REP_R1
#define REP_R1 1
#endif
#ifndef REP_CONV
#define REP_CONV 1
#endif
struct Params {
    const float* in[23];
    float* out;
    unsigned char* ws;
};

__device__ __forceinline__ int win_src_col(int n) {
    if (n < 2048) { const int base = n & 1024, r = n & 1023, t = r >> 8, p = r & 255, bj = p >> 7, i = p & 127; return base + (2 * t + (i >> 6)) * 128 + (i & 63) + 64 * bj; }
    if (n < 6144) return n;
    if (n < 8192) { const int r = n - 6144, t = r >> 8, p = r & 255; return p < 128 ? 6144 + 128 * t + p : 7168 + 128 * t + (p - 128); }
    return n;
}
__device__ __forceinline__ void transpose_item(const float* Wsrc  , int ldw, int K, bf16_t* WTrow  , int k0, LAS float* scr, int lane,
                                               const float* gk = nullptr, const float* bk = nullptr, float* c1 = nullptr, float* c2 = nullptr, const float* bias_src = nullptr) {
    { f32x4 wv[8];
      const float* wp = Wsrc + (size_t)(k0 + (lane >> 3)) * ldw + 4 * (lane & 7);
#pragma unroll
      for (int i = 0; i < 8; ++i) wv[i] = *(const f32x4*)(wp + (size_t)(8 * i) * ldw);
#pragma unroll
      for (int i = 0; i < 8; ++i)
#pragma unroll
          for (int t = 0; t < 4; ++t) scr[(8 * i + (lane >> 3)) * 33 + 4 * (lane & 7) + t] = wv[i][t]; }
    asm volatile("s_waitcnt lgkmcnt(0)" ::: "memory");
    if (gk) {
        const int n = lane & 31, kh = lane >> 5; float a1 = 0.f, a2 = 0.f;
        f32x4 g4v[8], b4v[8];
#pragma unroll
        for (int i = 0; i < 8; ++i) { g4v[i] = *(const f32x4*)(gk + k0 + kh * 32 + 4 * i); b4v[i] = *(const f32x4*)(bk + k0 + kh * 32 + 4 * i); }
#pragma unroll
        for (int kk = 0; kk < 32; ++kk) { const int k = kh * 32 + kk; const float w = scr[k * 33 + n]; a1 += bf_lo(cvt_pk_bf16(w * g4v[kk >> 2][kk & 3], 0.f)); a2 += b4v[kk >> 2][kk & 3] * w; }
        a1 += __shfl_xor(a1, 32); a2 += __shfl_xor(a2, 32);
        if (lane < 32) { if (k0 == 0 && bias_src) a2 += bias_src[n]; atomicAdd(c1 + n, a1); atomicAdd(c2 + n, a2); }
    }
    const int c = lane & 7;
    float gs[8];
    { f32x4 ga = {1.f, 1.f, 1.f, 1.f}, gb = ga; if (gk) { ga = *(const f32x4*)(gk + k0 + 8 * c); gb = *(const f32x4*)(gk + k0 + 8 * c + 4); }
#pragma unroll
      for (int j = 0; j < 4; ++j) { gs[j] = ga[j]; gs[4 + j] = gb[j]; } }
#pragma unroll
    for (int j = 0; j < 4; ++j) { const int n = (lane >> 3) + 8 * j; const LAS float* sp = scr + (8 * c) * 33 + n;
        u32x4 o; o.x = cvt_pk_bf16(sp[0 * 33] * gs[0], sp[1 * 33] * gs[1]); o.y = cvt_pk_bf16(sp[2 * 33] * gs[2], sp[3 * 33] * gs[3]); o.z = cvt_pk_bf16(sp[4 * 33] * gs[4], sp[5 * 33] * gs[5]); o.w = cvt_pk_bf16(sp[6 * 33] * gs[6], sp[7 * 33] * gs[7]);
        *(u32x4*)(WTrow + (size_t)n * K + k0 + 8 * c) = o; }
    asm volatile("s_waitcnt lgkmcnt(0)" ::: "memory");
}

__device__ __forceinline__ void ln_pass(const float* T, const float* g, const float* bta, float* Xf, bf16_t* Xb, int gw, int NGW, int lane) {
    f32x4 gv[4], bv[4];
#pragma unroll
    for (int j = 0; j < 4; ++j) { gv[j] = *(const f32x4*)(g + 4 * lane + 256 * j); bv[j] = *(const f32x4*)(bta + 4 * lane + 256 * j); }
    for (int row = gw; row < MTOK; row += 2 * NGW) {
        const int row2 = row + NGW;
        const bool has2 = row2 < MTOK;
        const float* tr = T + (size_t)row * DM + 4 * lane; const float* tr2 = T + (size_t)(has2 ? row2 : row) * DM + 4 * lane;
        f32x4 v[4], u[4]; float s = 0.f, q = 0.f, s_2 = 0.f, q_2 = 0.f;
#pragma unroll
        for (int j = 0; j < 4; ++j) { v[j] = *(const f32x4*)(tr + 256 * j); u[j] = *(const f32x4*)(tr2 + 256 * j); }
#pragma unroll
        for (int j = 0; j < 4; ++j) { s += (v[j][0] + v[j][1]) + (v[j][2] + v[j][3]); q += (v[j][0] * v[j][0] + v[j][1] * v[j][1]) + (v[j][2] * v[j][2] + v[j][3] * v[j][3]);
            s_2 += (u[j][0] + u[j][1]) + (u[j][2] + u[j][3]); q_2 += (u[j][0] * u[j][0] + u[j][1] * u[j][1]) + (u[j][2] * u[j][2] + u[j][3] * u[j][3]); }
        wave_sum2(s, q); wave_sum2(s_2, q_2);
        const float mean = s * (1.f / DM), rstd = 1.0f / sqrtf(fmaxf(q * (1.f / DM) - mean * mean, 0.f) + LN_EPS);
        const float mean2 = s_2 * (1.f / DM), rstd2 = 1.0f / sqrtf(fmaxf(q_2 * (1.f / DM) - mean2 * mean2, 0.f) + LN_EPS);
#pragma unroll
        for (int j = 0; j < 4; ++j) { const f32x4 y = (v[j] - mean) * rstd * gv[j] + bv[j]; *(f32x4*)(Xf + (size_t)row * DM + 4 * lane + 256 * j) = y;
            if (Xb) { u32x2 w; w.x = cvt_pk_bf16(y[0], y[1]); w.y = cvt_pk_bf16(y[2], y[3]); *(u32x2*)(Xb + (size_t)row * DM + 4 * lane + 256 * j) = w; } }
        if (has2) {
#pragma unroll
            for (int j = 0; j < 4; ++j) { const f32x4 y = (u[j] - mean2) * rstd2 * gv[j] + bv[j]; *(f32x4*)(Xf + (size_t)row2 * DM + 4 * lane + 256 * j) = y;
                if (Xb) { u32x2 w; w.x = cvt_pk_bf16(y[0], y[1]); w.y = cvt_pk_bf16(y[2], y[3]); *(u32x2*)(Xb + (size_t)row2 * DM + 4 * lane + 256 * j) = w; } } }
    }
}

__device__ __forceinline__ int swz(int row, int chunk) { return row * 256 + ((chunk ^ (row & 15)) << 4); }
#define MFMA32(a, b, c) __builtin_amdgcn_mfma_f32_32x32x16_bf16((a), (b), (c), 0, 0, 0)

#define XB_TMO      128
#define XB_XCNT(j)  (256  + 64 * (j))
#define XB_XSUB(j)  (1280 + 64 * (j))
#define XB_XGEN(j)  (2304 + 64 * (j))
#define XB_TOP      3328
#define XB_TOPGEN   3392
#define XCD_BAR_WORDS 3456
#define XB_SPIN_CAP (1u << 18)
__device__ __forceinline__ unsigned xb_ld(unsigned* p)              { return __hip_atomic_load(p, __ATOMIC_RELAXED, __HIP_MEMORY_SCOPE_AGENT); }
__device__ __forceinline__ unsigned xb_add(unsigned* p, unsigned v) { return __hip_atomic_fetch_add(p, v, __ATOMIC_RELAXED, __HIP_MEMORY_SCOPE_AGENT); }
__device__ __forceinline__ unsigned xb_xcc_id() { return (unsigned)__builtin_amdgcn_s_getreg((3 << 11) | 20) & 0xFu; }
#define XB_SPIN(cond, bar) do { unsigned _sp = 0; while (cond) { __builtin_amdgcn_s_sleep(1); \
    if ((++_sp & 255u) == 0u) { if (xb_ld(&(bar)[XB_TMO])) break; if (_sp > XB_SPIN_CAP) { atomicAdd(&(bar)[XB_TMO], 1u); break; } } } } while (0)
struct XcdBarrier { unsigned* bar; unsigned x; volatile LAS unsigned* st; };
__device__ __forceinline__ XcdBarrier xcd_barrier_post(unsigned* bar, volatile LAS unsigned* st) {
    XcdBarrier b; b.bar = bar; b.x = xb_xcc_id(); b.st = st;
    if (threadIdx.x == 0) (void)xb_add(&bar[XB_XCNT(b.x)], 1u);
    return b;
}
__device__ __forceinline__ void xcd_barrier_complete(unsigned* bar, unsigned x, unsigned& nloc, unsigned& nx) {
    const unsigned G = gridDim.x * gridDim.y * gridDim.z;
    unsigned sum, cnt, mine, sp = 0u;
    for (;;) {
        sum = 0u; cnt = 0u; mine = 0u;
#pragma unroll
        for (unsigned j = 0; j < 16; ++j) { const unsigned c = xb_ld(&bar[XB_XCNT(j)]); sum += c; cnt += (c > 0u) ? 1u : 0u; mine = (j == x) ? c : mine; }
        if (sum == G) break;
        __builtin_amdgcn_s_sleep(1);
        if ((++sp & 255u) == 0u) { if (xb_ld(&bar[XB_TMO])) break; if (sp > XB_SPIN_CAP) { atomicAdd(&bar[XB_TMO], 1u); break; } }
    }
    nloc = mine > 0u ? mine : 1u; nx = cnt > 0u ? cnt : 1u;
}
__device__ __forceinline__ void xcd_barrier(const XcdBarrier& b) {
    asm volatile("s_waitcnt vmcnt(0)" ::: "memory");
    __syncthreads();
    if (threadIdx.x == 0) {
        unsigned* bar = b.bar;
        __builtin_amdgcn_s_waitcnt(0);
        unsigned nloc = b.st[0], nx = b.st[1];
        if (nloc == 0u) { xcd_barrier_complete(bar, b.x, nloc, nx); b.st[0] = nloc; b.st[1] = nx; }
        const unsigned old = xb_add(&bar[XB_XSUB(b.x)], 1u);
        const unsigned gen = old / nloc;
        if (old + 1u == (gen + 1u) * nloc) {
            __builtin_amdgcn_fence(__ATOMIC_RELEASE, "agent");
            asm volatile("s_waitcnt vmcnt(0)" ::: "memory");
            const unsigned og = xb_add(&bar[XB_TOP], 1u);
            const unsigned tg = og / nx;
            if (og + 1u == (tg + 1u) * nx) xb_add(&bar[XB_TOPGEN], 1u);
            else XB_SPIN(xb_ld(&bar[XB_TOPGEN]) == tg, bar);
            __builtin_amdgcn_fence(__ATOMIC_ACQUIRE, "agent");
            xb_add(&bar[XB_XGEN(b.x)], 1u);
            asm volatile("s_waitcnt vmcnt(0)" ::: "memory");
        } else {
            XB_SPIN(xb_ld(&bar[XB_XGEN(b.x)]) == gen, bar);
            __builtin_amdgcn_fence(__ATOMIC_ACQUIRE, "agent");
            asm volatile("s_waitcnt vmcnt(0)" ::: "memory");
        }
    }
    __syncthreads();
}
constexpr size_t OFF_BAR = OFF_CVEC + CVEC_BYTES;
static_assert(OFF_BAR % 256 == 0 && OFF_BAR + XCD_BAR_WORDS * 4 <= 64 * MiB, "barrier words");
constexpr int LDS_ST_OFF = 147456;

__global__ void __launch_bounds__(512, 2) fwd_kernel(Params p) {
    extern __shared__ __attribute__((aligned(16))) unsigned char lds_raw[];
    LAS unsigned char* lds = (LAS unsigned char*)lds_raw;
    if (p.ws == nullptr) cg::this_grid().sync();
    if (threadIdx.x < 4) *(volatile LAS unsigned*)(lds + LDS_ST_OFF + 4 * threadIdx.x) = 0u;
    __syncthreads();
    const XcdBarrier xbar = xcd_barrier_post((unsigned*)(p.ws + OFF_BAR), (volatile LAS unsigned*)(lds + LDS_ST_OFF));
    const int G = gridDim.x, bx = blockIdx.x;
#define GSYNC() xcd_barrier(xbar)
#define PHASE_IDS int tid = threadIdx.x; asm volatile("" : "+v"(tid)); const int lane = tid & 63, wave = __builtin_amdgcn_readfirstlane(tid >> 6); const int gw = bx * 8 + wave, NGW = G * 8; (void)gw; (void)NGW; (void)lane;
    unsigned char* ws = p.ws;
    const float* x = p.in[0];
    float* C1IN = (float*)(ws + OFF_CVEC); float* C2IN = C1IN + INW; float* C1F2 = C2IN + INW; float* C2F2 = C1F2 + 2 * DFF;
    f32x2* STATP1 = (f32x2*)(ws + OFF_STATP1); f32x2* STATP2 = (f32x2*)(ws + OFF_STATP2);
    unsigned long long* XBUF = (unsigned long long*)(ws + OFF_XBUF); unsigned* PCNT = (unsigned*)(ws + OFF_CVEC + (size_t)(2 * INW + 4 * DFF) * 4);
    bf16_t* W1GU = (bf16_t*)(ws + OFF_W1GU); bf16_t* W1D = (bf16_t*)(ws + OFF_W1D); bf16_t* WIN = (bf16_t*)(ws + OFF_WIN); bf16_t* WRO = (bf16_t*)(ws + OFF_WRO);
    bf16_t* WCO = (bf16_t*)(ws + OFF_WCO); bf16_t* WOUT = (bf16_t*)(ws + OFF_WOUT); bf16_t* W2GU = (bf16_t*)(ws + OFF_W2GU); bf16_t* W2D = (bf16_t*)(ws + OFF_W2D);
    bf16_t* XB = (bf16_t*)(ws + SLOTP(0));
    bf16_t* HB = (bf16_t*)(ws + SLOTP(1));
    float* TRES = p.out;
    bf16_t* VT = (bf16_t*)(ws + SLOTP(2));
    bf16_t* SNAP = (bf16_t*)(ws + SLOTP(5));
    bf16_t* QB = (bf16_t*)(ws + SLOTP(1)); bf16_t* KB = (bf16_t*)(ws + SLOTP(4));
    bf16_t* UB = (bf16_t*)(ws + SLOTP(1)); bf16_t* GRB = (bf16_t*)(ws + SLOTP(2)); bf16_t* GCB = (bf16_t*)(ws + SLOTP(3));
    bf16_t* ACB = (bf16_t*)(ws + SLOTP(4));
    bf16_t* T1 = (bf16_t*)(ws + SLOTP(1));
    bf16_t* MGB = GRB;

    for (int rep = 0; rep < REP_P0; ++rep) {
        PHASE_IDS
        LAS float* scr = (LAS float*)(lds + wave * 8448);
        constexpr int NI0 = 16 * 176, NI1 = 44 * 32, NI2 = 16 * 320, NI3 = 32 * 32, NI4 = 16 * 32;
        constexpr int NITEMS = 2 * NI0 + 2 * NI1 + NI2 + NI3 + 2 * NI4;
        for (int it = gw; it < NITEMS; it += NGW) {
            int r = it;
            if (r < 2 * NI0) { const int l2 = r >= NI0; r -= l2 * NI0; const int kb = r / 176, nb = r % 176, n0 = nb * 32, t = n0 >> 8, pp = n0 & 255;
                const float* src = p.in[l2 ? (pp < 128 ? 18 : 19) : (pp < 128 ? 1 : 2)] + 128 * t + (pp & 127);
                if (l2) transpose_item(src, DFF, DM, W2GU + (size_t)n0 * DM, kb * 64, scr, lane, p.in[16], p.in[17], C1F2 + n0, C2F2 + n0, nullptr);
                else transpose_item(src, DFF, DM, W1GU + (size_t)n0 * DM, kb * 64, scr, lane);
                continue; }
            r -= 2 * NI0;
            if (r < 2 * NI1) { const int l2 = r >= NI1; r -= l2 * NI1; const int kb = r / 32, nb = r % 32;
                transpose_item(p.in[l2 ? 20 : 3] + nb * 32, DM, DFF, (l2 ? W2D : W1D) + (size_t)nb * 32 * DFF, kb * 64, scr, lane); continue; }
            r -= 2 * NI1;
            if (r < NI2) { const int kb = r / 320, nb = r % 320, n0 = nb * 32;
                transpose_item(p.in[6] + win_src_col(n0), INW, DM, WIN + (size_t)n0 * DM, kb * 64, scr, lane, p.in[4], p.in[5], C1IN + n0, C2IN + n0, p.in[7] + win_src_col(n0)); continue; }
            r -= NI2;
            if (r < NI3) { const int kb = r / 32, nb = r % 32;
                transpose_item(p.in[13] + nb * 32, DM, 2048, WRO + (size_t)nb * 32 * 2048, kb * 64, scr, lane); continue; }
            r -= NI3;
            { const int l2 = r >= NI4; r -= l2 * NI4; const int kb = r / 32, nb = r % 32;
                transpose_item(p.in[l2 ? 15 : 14] + nb * 32, DM, DM, (l2 ? WOUT : WCO) + (size_t)nb * 32 * DM, kb * 64, scr, lane); }
        }
        const int gt = bx * 512 + tid, NGT = G * 512;
        for (size_t i = gt; i < (size_t)MTOK * DM / 8; i += (size_t)4 * NGT) {
            f32x4 a[4], b[4];
#pragma unroll
            for (int q = 0; q < 4; ++q) { const size_t j = i + (size_t)q * NGT; a[q] = *(const f32x4*)(x + j * 8); b[q] = *(const f32x4*)(x + j * 8 + 4); }
#pragma unroll
            for (int q = 0; q < 4; ++q) { const size_t j = i + (size_t)q * NGT; *(u32x4*)(XB + j * 8) = pack8(a[q], b[q]); } }
    }
    GSYNC();
    pg8::StaticOrder S;
    { pg8::Gemm g{XB, W1GU, DM, DM, DM}; S.init(MTOK, 2 * DFF, G, bx); pg8::EpiGU<false> E{HB, nullptr, nullptr, nullptr}; pg8::gemm_phase<pg8::EpiGU<false>, 0>(lds, g, S, E); }
    GSYNC();
    { pg8::Gemm g{HB, W1D, DFF, DFF, DFF}; S.init(MTOK, DM, G, bx); pg8::EpiResLn<0> E{x, XB, STATP1, nullptr, nullptr, nullptr, 0.5f}; pg8::gemm_phase<pg8::EpiResLn<0>, 0>(lds, g, S, E); }
    GSYNC();
    { pg8::Gemm g{WIN + (size_t)2048 * DM, XB, DM, DM, DM}; S.init(2048, MTOK, G, bx); pg8::EpiVT E{VT, STATP1, C1IN + 2048, C2IN + 2048}; pg8::gemm_phase<pg8::EpiVT, 0>(lds, g, S, E); }
    { pg8::Gemm g{XB, WIN, DM, DM, DM}; S.init(MTOK, 2048, G, bx); pg8::EpiQK E{QB, KB, STATP1, C1IN, C2IN}; pg8::gemm_phase<pg8::EpiQK, 0>(lds, g, S, E); }
    GSYNC();
    for (int rep = 0; rep < REP_R1; ++rep) {
        PHASE_IDS
        const int lr = lane & 31, lh = lane >> 5;
        for (int it0 = bx; it0 < 256; it0 += G) {
            const int item = (G == 256) ? ((it0 & 7) * 32 + (it0 >> 3)) : it0;
            const int bh = item >> 2, es = item & 3, h = bh & 7, db = wave >> 1, eb = wave & 1;
            const float decay = exp2f(128.0f * log2gamma(h));
            f32x16 st; for (int r = 0; r < 16; ++r) st[r] = 0.f;
            unsigned ktr0, ktr1;
            { const int g = lane >> 4, q = (lane >> 2) & 3, pp = lane & 3, chk = 4 * db + 2 * (g & 1) + (pp >> 1);
              const int r0 = 8 * (g >> 1) + q, r1 = r0 + 4;
              ktr0 = (unsigned)(256 * r0 + 16 * (chk ^ (((r0 & 3) << 2) | ((r0 >> 2) & 3))) + 8 * (pp & 1));
              ktr1 = (unsigned)(256 * r1 + 16 * (chk ^ (((r1 & 3) << 2) | ((r1 >> 2) & 3))) + 8 * (pp & 1)); }
            const char* ksrc = (const char*)(KB + (size_t)bh * SEQ * DK);
            const int krow = lane >> 4, kslot = lane & 15;
            const char* vsrc = (const char*)(VT + ((size_t)(bh * 32) * 8 + 2 * es) * 4096) + lane * 16;
#define R1_ISSUE(n) do { const unsigned sbase = (unsigned)((n) % 3) * 49152u; _Pragma("unroll") for (int pc = 0; pc < 6; ++pc) { const int piece = wave * 6 + pc; \
            const char* gsrc = piece < 32 ? ksrc + (size_t)(n) * 32768 + (4 * piece + krow) * 256 + ((kslot ^ ((krow << 2) | (piece & 3))) << 4) : vsrc + (size_t)(n) * 65536 + (piece - 32) * 1024; \
            __builtin_amdgcn_global_load_lds((const unsigned*)gsrc, (LAS unsigned*)(lds + sbase + piece * 1024), 16, 0, 0); } } while (0)
            R1_ISSUE(0); R1_ISSUE(1);
            asm volatile("s_waitcnt vmcnt(6)" ::: "memory");
            for (int n = 0; n < 31; ++n) {
                asm volatile("s_waitcnt vmcnt(6)\n\ts_waitcnt lgkmcnt(0)" ::: "memory");
                __builtin_amdgcn_s_barrier();
                asm volatile("" ::: "memory"); __builtin_amdgcn_sched_barrier(0);
                if (n + 2 < 31) R1_ISSUE(n + 2);
                const LAS unsigned char* sb = lds + (unsigned)(n % 3) * 49152u;
                bf16x8 kf[8], vf[8];
#pragma unroll
                for (int ks = 0; ks < 8; ++ks) {
                    const s16x4 lo = __builtin_amdgcn_ds_read_tr16_b64_v4i16((LAS s16x4*)(sb + ktr0 + ks * 4096)), hi = __builtin_amdgcn_ds_read_tr16_b64_v4i16((LAS s16x4*)(sb + ktr1 + ks * 4096));
                    kf[ks] = __builtin_shufflevector(lo, hi, 0, 1, 2, 3, 4, 5, 6, 7);
                    vf[ks] = *(const LAS bf16x8*)(sb + 32768 + (eb * 8 + ks) * 1024 + lane * 16); }
                st = st * decay;
#pragma unroll
                for (int ks = 0; ks < 8; ++ks) st = MFMA32(kf[ks], vf[ks], st);
#pragma unroll
                for (int k = 0; k < 4; k += 2) {
                    u32x2 a, b; a.x = cvt_pk_bf16(st[4 * k], st[4 * k + 1]); a.y = cvt_pk_bf16(st[4 * k + 2], st[4 * k + 3]); b.x = cvt_pk_bf16(st[4 * k + 4], st[4 * k + 5]); b.y = cvt_pk_bf16(st[4 * k + 6], st[4 * k + 7]);
                    { auto r = __builtin_amdgcn_permlane32_swap(a.x, b.x, false, false); a.x = r[0]; b.x = r[1]; } { auto r = __builtin_amdgcn_permlane32_swap(a.y, b.y, false, false); a.y = r[0]; b.y = r[1]; }
                    *(u32x4*)(SNAP + ((((size_t)(bh * 32 + n + 1) * 8 + 2 * es + eb) * 8 + 2 * db + (k >> 1)) * 64 + lh * 32 + lr) * 8) = (u32x4){a.x, a.y, b.x, b.y}; }
            }
#undef R1_ISSUE
            asm volatile("s_waitcnt vmcnt(0)" ::: "memory");
            __syncthreads();
        }
    }
    GSYNC();
    {
        PHASE_IDS
        const int w = wave;
        LAS unsigned char* Qs = lds; LAS unsigned char* Ks = lds + 32768; LAS unsigned char* Ps = lds + 65536; LAS f32x2* STAT = (LAS f32x2*)(lds + 98304);
        u32x4 qv[4], kv[4]; bf16x8 stf[8], vtf[8];
#define R2_LOAD_QK(it) do { const u32x4* qsrc_ = (const u32x4*)(QB + (size_t)(it) * 128 * DK); const u32x4* ksrc_ = (const u32x4*)(KB + (size_t)(it) * 128 * DK); \
            _Pragma("unroll") for (int k = 0; k < 4; ++k) { qv[k] = qsrc_[tid + 512 * k]; kv[k] = ksrc_[tid + 512 * k]; } } while (0)
#define R2_LOAD_ST(it) do { _Pragma("unroll") for (int ks = 0; ks < 8; ++ks) stf[ks] = *(const bf16x8*)(SNAP + (((size_t)(it) * 8 + w) * 8 + ks) * 512 + lane * 8); } while (0)
#define R2_LOAD_VT(it) do { _Pragma("unroll") for (int ks = 0; ks < 8; ++ks) vtf[ks] = *(const bf16x8*)(VT + (((size_t)(it) * 8 + w) * 8 + ks) * 512 + lane * 8); } while (0)
        if (bx < 2048) { R2_LOAD_QK(bx); if ((bx & 31) > 0) R2_LOAD_ST(bx); R2_LOAD_VT(bx); }
        for (int item = bx; item < 2048; item += G) {
            const int bh = item >> 5, n = item & 31, h = bh & 7; const float lg = log2gamma(h);
            const int nxt = item + G; const bool has_nxt = nxt < 2048;
            int lane_i = lane; asm volatile("" : "+v"(lane_i));
            const int lr = lane_i & 31, lh = lane_i >> 5;
#pragma unroll
            for (int k = 0; k < 4; ++k) { const int idx = tid + 512 * k, row = idx >> 4, ch = idx & 15; *(LAS u32x4*)(Qs + swz(row, ch)) = qv[k]; *(LAS u32x4*)(Ks + swz(row, ch)) = kv[k]; }
            __syncthreads();
            { const int ib = w >> 1;
#pragma unroll
              for (int tt = 0; tt < 2; ++tt) { const int jb = 2 * (w & 1) + tt;
                if (jb <= ib) { f32x16 sa; for (int r = 0; r < 16; ++r) sa[r] = 0.f;
#pragma unroll
                    for (int ks = 0; ks < 8; ++ks) { const bf16x8 a = *(const LAS bf16x8*)(Ks + swz(32 * jb + lr, 2 * ks + lh)); const bf16x8 bq = *(const LAS bf16x8*)(Qs + swz(32 * ib + lr, 2 * ks + lh)); sa = MFMA32(a, bq, sa); }
                    const int i = 32 * ib + lr; const float rowf = exp2f((float)(i - 127) * lg);
#pragma unroll
                    for (int g4 = 0; g4 < 4; ++g4) { const int j0 = 32 * jb + 8 * g4 + 4 * lh; float pv[4];
#pragma unroll
                        for (int xx = 0; xx < 4; ++xx) { const int dd = i - j0 - xx; pv[xx] = dd >= 0 ? sa[4 * g4 + xx] * rowf : 0.f; }
                        u32x2 wv; wv.x = cvt_pk_bf16(pv[0], pv[1]); wv.y = cvt_pk_bf16(pv[2], pv[3]);
                        *(LAS u32x2*)(Ps + i * 256 + (((j0 >> 3) ^ (i & 15)) << 4) + (j0 & 7) * 2) = wv; } } } }
            f32x16 acc[4];
#pragma unroll
            for (int q = 0; q < 4; ++q) for (int r = 0; r < 16; ++r) acc[q][r] = 0.f;
            if (n > 0) {
#pragma unroll
                for (int q = 0; q < 4; ++q) {
#pragma unroll
                    for (int ks = 0; ks < 8; ++ks) { const bf16x8 bq = *(const LAS bf16x8*)(Qs + swz(32 * q + lr, 2 * ks + lh)); acc[q] = MFMA32(stf[ks], bq, acc[q]); }
                    acc[q] = acc[q] * exp2f((float)(32 * q + lr + 1) * lg); }
            }
            if (has_nxt && (nxt & 31) > 0) R2_LOAD_ST(nxt);
            __syncthreads();
            if (has_nxt) R2_LOAD_QK(nxt);
#pragma unroll
            for (int q = 0; q < 4; ++q) {
#pragma unroll
                for (int ks = 0; ks < 2 * (q + 1); ++ks) { const bf16x8 bp = *(const LAS bf16x8*)(Ps + swz(32 * q + lr, 2 * ks + lh)); acc[q] = MFMA32(vtf[ks], bp, acc[q]); } }
            if (has_nxt) R2_LOAD_VT(nxt);
#pragma unroll
            for (int q = 0; q < 4; ++q) { float s1 = 0.f, s2 = 0.f;
#pragma unroll
                for (int r = 0; r < 16; ++r) { s1 += acc[q][r]; s2 += acc[q][r] * acc[q][r]; }
                s1 += __shfl_xor(s1, 32); s2 += __shfl_xor(s2, 32);
                if (lh == 0) STAT[w * 128 + 32 * q + lr] = (f32x2){s1, s2}; }
            __syncthreads();
            f32x4 gnv[4];
#pragma unroll
            for (int g4 = 0; g4 < 4; ++g4) gnv[g4] = *(const f32x4*)(p.in[8] + h * DV + 32 * w + 8 * g4 + 4 * lh);
#pragma unroll
            for (int q = 0; q < 4; ++q) { const int i = 32 * q + lr; float s1 = 0.f, s2 = 0.f;
#pragma unroll
                for (int w2 = 0; w2 < 8; ++w2) { const f32x2 t = STAT[w2 * 128 + i]; s1 += t[0]; s2 += t[1]; }
                const float mean = s1 * (1.f / DV); const float var = fmaxf(s2 * (1.f / DV) - mean * mean, 0.f); const float rstd = 1.0f / sqrtf(var + LN_EPS);
                bf16_t* orow = SNAP + ((size_t)(bh * SEQ + 128 * n + i)) * DV + 32 * w + 8 * lh;
                u32x2 wv[4];
#pragma unroll
                for (int g4 = 0; g4 < 4; ++g4) { wv[g4].x = cvt_pk_bf16((acc[q][4 * g4] - mean) * rstd * gnv[g4][0], (acc[q][4 * g4 + 1] - mean) * rstd * gnv[g4][1]);
                    wv[g4].y = cvt_pk_bf16((acc[q][4 * g4 + 2] - mean) * rstd * gnv[g4][2], (acc[q][4 * g4 + 3] - mean) * rstd * gnv[g4][3]); }
#pragma unroll
                for (int k = 0; k < 4; k += 2) { u32x2 a = wv[k], b = wv[k + 1];
                    { auto r = __builtin_amdgcn_permlane32_swap(a.x, b.x, false, false); a.x = r[0]; b.x = r[1]; } { auto r = __builtin_amdgcn_permlane32_swap(a.y, b.y, false, false); a.y = r[0]; b.y = r[1]; }
                    *(u32x4*)(orow + 8 * k) = (u32x4){a.x, a.y, b.x, b.y}; } }
        }
    }
    GSYNC();
    { pg8::Gemm g{XB, WIN + (size_t)4096 * DM, DM, DM, DM}; S.init(MTOK, 6144, G, bx);
      pg8::EpiGUG E{pg8::EpiG{SNAP, STATP1, C1IN + 4096, C2IN + 4096}, pg8::EpiU{UB, STATP1, C1IN + 6144, C2IN + 6144}, pg8::EpiGates{GRB, GCB, STATP1, C1IN + 8192, C2IN + 8192}};
      pg8::gemm_phase<pg8::EpiGUG, 0>(lds, g, S, E); }
    GSYNC();
    for (int rep = 0; rep < REP_CONV; ++rep) {
        PHASE_IDS
        LAS float* Y = (LAS float*)lds;
        LAS float* GB = (LAS float*)(lds + 131072);
        const int c2 = 2 * tid; const unsigned coff4 = (unsigned)c2 * 4u, coff2 = (unsigned)c2 * 2u;
        *(LAS f32x2*)(GB + c2) = *(const f32x2*)((const char*)p.in[11] + coff4); *(LAS f32x2*)(GB + DM + c2) = *(const f32x2*)((const char*)p.in[12] + coff4);
        for (int item = bx; item < 256; item += G) {
            const int tb = 128 * item, sstart = tb & (SEQ - 1);
            f32x2 wk[31];
#pragma unroll
            for (int tp = 0; tp < 31; ++tp) { const float* wp = p.in[9] + tp * DM; asm volatile("" : "+s"(wp)); wk[tp] = *(const f32x2*)((const char*)wp + coff4); }
            const f32x2 cbias = *(const f32x2*)((const char*)p.in[10] + coff4);
            f32x2 win[46]; unsigned nx[16];
#pragma unroll
            for (int q = 0; q < 16; ++q) nx[q] = *(const unsigned*)((const char*)(UB + (size_t)(tb + q) * DM) + coff2);
#pragma unroll
            for (int q = 0; q < 30; ++q) { unsigned uu = 0u; if (sstart != 0) uu = *(const unsigned*)((const char*)(UB + (size_t)(tb - 30 + q) * DM) + coff2); win[q] = (f32x2){bf_lo(uu), bf_hi(uu)}; }
#define CONV_FMA(sbv) do { const int t0_ = tb + 16 * (sbv); LAS float* Yw = Y + ((sbv) & 1) * 16 * DM; \
                _Pragma("unroll") for (int q = 0; q < 16; ++q) win[30 + q] = (f32x2){bf_lo(nx[q]), bf_hi(nx[q])}; \
                _Pragma("unroll") for (int q = 0; q < 16; ++q) nx[q] = *(const unsigned*)((const char*)(UB + (size_t)(t0_ + 16 + q) * DM) + coff2);     \
                _Pragma("unroll") for (int q = 0; q < 16; ++q) { f32x2 a = cbias; _Pragma("unroll") for (int tp = 0; tp < 31; ++tp) a += wk[tp] * win[q + tp]; *(LAS f32x2*)(Yw + q * DM + c2) = a; } \
                _Pragma("unroll") for (int q = 0; q < 30; ++q) win[q] = win[q + 16]; } while (0)
#define CONV_LN(sbv) do { const int t0_ = tb + 16 * (sbv); const LAS float* Yr = Y + ((sbv) & 1) * 16 * DM; \
                _Pragma("unroll") for (int tk = 0; tk < 2; ++tk) { const int tok = wave + 8 * tk; const LAS float* yr = Yr + tok * DM + 4 * lane; f32x4 v[4]; float s1 = 0.f, s2 = 0.f; \
                  _Pragma("unroll") for (int j = 0; j < 4; ++j) { v[j] = *(const LAS f32x4*)(yr + 256 * j); s1 += (v[j][0] + v[j][1]) + (v[j][2] + v[j][3]); s2 += (v[j][0] * v[j][0] + v[j][1] * v[j][1]) + (v[j][2] * v[j][2] + v[j][3] * v[j][3]); } \
                  wave_sum2(s1, s2); \
                  const float mean = s1 * (1.f / DM); const float rstd = 1.0f / sqrtf(fmaxf(s2 * (1.f / DM) - mean * mean, 0.f) + LN_EPS); \
                  _Pragma("unroll") for (int j = 0; j < 4; ++j) { const f32x4 lgj = *(const LAS f32x4*)(GB + 4 * lane + 256 * j), lbj = *(const LAS f32x4*)(GB + DM + 4 * lane + 256 * j); f32x4 y = (v[j] - mean) * rstd * lgj + lbj; \
                      _Pragma("unroll") for (int e = 0; e < 4; ++e) y[e] = siluf_(y[e]); \
                      u32x2 wv; wv.x = cvt_pk_bf16(y[0], y[1]); wv.y = cvt_pk_bf16(y[2], y[3]); *(u32x2*)(ACB + (size_t)(t0_ + tok) * DM + 4 * lane + 256 * j) = wv; } } } while (0)
            CONV_FMA(0);
            __syncthreads();
            for (int sb = 1; sb < 8; ++sb) { CONV_LN(sb - 1); CONV_FMA(sb); __syncthreads(); }
            CONV_LN(7);
#undef CONV_FMA
#undef CONV_LN
            __syncthreads();
        }
    }
    GSYNC();
    { pg8::Gemm g{SNAP, WRO, DV, 2048, 2048}; S.init(MTOK, DM, G, bx); pg8::EpiRO E{GRB, T1}; pg8::gemm_phase<pg8::EpiRO, 1>(lds, g, S, E); }
    { pg8::Gemm g{ACB, WCO, DM, DM, DM}; S.init(MTOK, DM, G, bx); pg8::EpiCO E{GCB, T1, MGB}; pg8::gemm_phase<pg8::EpiCO, 0>(lds, g, S, E); }
    GSYNC();
    { pg8::Gemm g{MGB, WOUT, DM, DM, DM}; S.init(MTOK, DM, G, bx); pg8::EpiResLn<1> E{nullptr, XB, STATP2, STATP1, p.in[4], p.in[5], 1.0f}; pg8::gemm_phase<pg8::EpiResLn<1>, 0>(lds, g, S, E); }
    GSYNC();
    { pg8::Gemm g{XB, W2GU, DM, DM, DM}; S.init(MTOK, 2 * DFF, G, bx); pg8::EpiGU<true> E{HB, STATP2, C1F2, C2F2}; pg8::gemm_phase<pg8::EpiGU<true>, 0>(lds, g, S, E); }
    GSYNC();
    { pg8::Gemm g{HB, W2D, DFF, DFF, DFF}; S.init(MTOK, DM, G, bx); pg8::EpiFinalLn E{p.out, XB, STATP2, p.in[16], p.in[17], 0.5f, XBUF, PCNT, p.in[21], p.in[22]}; pg8::gemm_phase<pg8::EpiFinalLn, 0>(lds, g, S, E); }
}

extern "C" void kernel_launch(void* const* d_in, const int* in_sizes, int n_in, void* d_out, int out_size, void* d_ws, size_t ws_size, hipStream_t stream) {
    static int grid = 0;
    if (grid == 0) {
        if (n_in != 23 || out_size != MTOK * DM || ws_size < WS_NEED) { fprintf(stderr, "kernel_launch: unexpected problem (n_in %d, out %d, ws %zu)\n", n_in, out_size, ws_size); grid = -1; return; }
        int dev = 0, cus = 0, per_cu = 0;
        hipGetDevice(&dev); hipDeviceGetAttribute(&cus, hipDeviceAttributeMultiprocessorCount, dev);
        if (hipFuncSetAttribute((const void*)fwd_kernel, hipFuncAttributeMaxDynamicSharedMemorySize, LDS_BYTES) != hipSuccess) { fprintf(stderr, "kernel_launch: hipFuncSetAttribute failed\n"); grid = -1; return; }
        if (hipOccupancyMaxActiveBlocksPerMultiprocessor(&per_cu, (const void*)fwd_kernel, 512, LDS_BYTES) != hipSuccess || per_cu < 1) { fprintf(stderr, "kernel_launch: occupancy query gives %d\n", per_cu); per_cu = 1; }
        (void)hipGetLastError();
        grid = cus;
    }
    if (grid < 0) return;
    Params p{};
    for (int i = 0; i < 23; ++i) p.in[i] = (const float*)d_in[i];
    p.out = (float*)d_out; p.ws = (unsigned char*)d_ws;
    (void)hipMemsetAsync((char*)d_ws + OFF_CVEC, 0, CVEC_BYTES + XCD_BAR_WORDS * 4, stream);
    void* args[] = {&p};
    hipError_t e = hipLaunchCooperativeKernel((const void*)fwd_kernel, dim3(grid), dim3(512), args, LDS_BYTES, stream);
    if (e != hipSuccess) fprintf(stderr, "kernel_launch: cooperative launch failed: %s (grid %d)\n", hipGetErrorString(e), grid);
}
```

```cpp
#include <hip/hip_runtime.h>
#include <hip/hip_cooperative_groups.h>
#include <cstdio>
#include <cstdint>
namespace cg = cooperative_groups;

#define LAS __attribute__((address_space(3)))
typedef unsigned short bf16_t;
typedef short bf16x8 __attribute__((ext_vector_type(8)));
typedef float f32x2 __attribute__((ext_vector_type(2)));
typedef float f32x4 __attribute__((ext_vector_type(4)));
typedef float f32x16 __attribute__((ext_vector_type(16)));
typedef unsigned u32x2 __attribute__((ext_vector_type(2)));
typedef unsigned u32x4 __attribute__((ext_vector_type(4)));
typedef short s16x4 __attribute__((ext_vector_type(4)));

constexpr int MTOK = 32768, DM = 1024, DFF = 2816, SEQ = 4096, NH = 8, DK = 128, DV = 256, INW = 10240;
constexpr float LN_EPS = 1e-5f;
constexpr float ALPHA = 1.189207115002721f;
constexpr float QSCALE = 0.08838834764831845f;

constexpr size_t MiB = 1u << 20;
constexpr size_t SZ_WGU = (size_t)2 * DFF * DM * 2, SZ_WD = (size_t)DM * DFF * 2, SZ_WIN = (size_t)INW * DM * 2;
constexpr size_t OFF_BIASP = 0;
constexpr size_t OFF_W1GU = 65536;
constexpr size_t OFF_W1D = OFF_W1GU + SZ_WGU;
constexpr size_t OFF_WIN = OFF_W1D + SZ_WD;
constexpr size_t OFF_WRO = OFF_WIN + SZ_WIN;
constexpr size_t OFF_WCO = OFF_WRO + (size_t)DM * 2048 * 2;
constexpr size_t OFF_WOUT = OFF_WCO + (size_t)DM * DM * 2;
constexpr size_t OFF_W2GU = OFF_WOUT + (size_t)DM * DM * 2;
constexpr size_t OFF_W2D = OFF_W2GU + SZ_WGU;
constexpr size_t OFF_COS = OFF_W2D + SZ_WD;
constexpr size_t OFF_SIN = OFF_COS + MiB;
constexpr size_t OFF_CVEC = OFF_SIN + MiB;
constexpr size_t CVEC_BYTES = (size_t)(2 * INW + 4 * DFF) * 4 + 128 * 256;
static_assert(OFF_CVEC + CVEC_BYTES <= 64 * MiB, "weights region");
constexpr size_t OFF_STATP1 = OFF_W1GU, OFF_STATP2 = OFF_W1GU + MiB, OFF_XBUF = OFF_W1GU + 2 * MiB;
constexpr size_t SLOT0 = 64 * MiB, SLOT = 64 * MiB;
#define SLOTP(i) (SLOT0 + (size_t)(i) * SLOT)
constexpr size_t WS_NEED = 512 * MiB;
constexpr int LDS_BYTES = 147456 + 256;

typedef __bf16 bf16x2v __attribute__((ext_vector_type(2)));
__device__ __forceinline__ unsigned cvt_pk_bf16(float lo, float hi) { const f32x2 v = {lo, hi}; return __builtin_bit_cast(unsigned, __builtin_convertvector(v, bf16x2v)); }
__device__ __forceinline__ float bf_lo(unsigned u) { return __uint_as_float(u << 16); }
__device__ __forceinline__ float bf_hi(unsigned u) { return __uint_as_float(u & 0xffff0000u); }
__device__ __forceinline__ float sigmoidf_(float x) { return __builtin_amdgcn_rcpf(1.0f + __expf(-x)); }
__device__ __forceinline__ float siluf_(float x) { return x * sigmoidf_(x); }
__device__ __forceinline__ u32x4 pack8(const f32x4 a, const f32x4 b) { u32x4 w; w.x = cvt_pk_bf16(a[0], a[1]); w.y = cvt_pk_bf16(a[2], a[3]); w.z = cvt_pk_bf16(b[0], b[1]); w.w = cvt_pk_bf16(b[2], b[3]); return w; }
__device__ __forceinline__ void unpack8(const u32x4 w, f32x4& a, f32x4& b) { a[0] = bf_lo(w.x); a[1] = bf_hi(w.x); a[2] = bf_lo(w.y); a[3] = bf_hi(w.y); b[0] = bf_lo(w.z); b[1] = bf_hi(w.z); b[2] = bf_lo(w.w); b[3] = bf_hi(w.w); }
__device__ __forceinline__ float log2gamma(int h) { return log2f(1.0f - exp2f(-5.0f - (float)h)); }
__device__ __forceinline__ float wave_sum(float v) {
#pragma unroll
    for (int o = 1; o < 64; o <<= 1) v += __shfl_xor(v, o);
    return v;
}

__device__ __forceinline__ void wave_sum2(float& a, float& b) {
#pragma unroll
    for (int o = 1; o < 64; o <<= 1) { const float ta = __shfl_xor(a, o), tb = __shfl_xor(b, o); a += ta; b += tb; }
}
namespace pg8 {
constexpr int BM = 256, BK = 64, HALF = 128, HTB = HALF * BK * 2, STAGE_BYTES = 8 * HTB, NXCD = 8, WGM = 8;
__host__ __device__ __forceinline__ int lds_byte(int r, int c) { const int st = (r >> 4) * 2 + (c >> 5), rr = r & 15, cc = c & 31, ob = rr * 64 + cc * 2; return st * 1024 + (ob ^ (((ob >> 9) & 1) << 5)); }
__host__ __device__ __forceinline__ void stage_rc(int b, int& R, int& C) { const int st = b / 1024, sb = b % 1024, swz = sb ^ (((sb >> 9) & 1) << 5); R = (st >> 1) * 16 + swz / 64; C = (st & 1) * 32 + (swz % 64) / 2; }
__host__ __device__ __forceinline__ int perm32(int rho) { const int n = rho >> 4, i = rho & 15; return 8 * (i >> 2) + 4 * n + (i & 3); }
struct Unit { int pm, pn; };
struct Gemm { const bf16_t* A; const bf16_t* Bt; int lda, ldb, K; };
struct StaticOrder {
    int nM, nN, nwg, G, c;
    __device__ void init(int M, int N, int G_, int c_) { nM = M / BM; nN = N / BM; nwg = nM * nN; G = G_; c = c_; }
    __device__ bool next(int i, Unit& u) const {
        const long L = (long)i * G + c; if (L >= nwg) return false;
        int wgid = (int)L; { const int q = nwg / NXCD, r = nwg % NXCD, xcd = wgid % NXCD, off = wgid / NXCD; wgid = (xcd < r ? xcd * (q + 1) : r * (q + 1) + (xcd - r) * q) + off; }
        const int nig = WGM * nN, gid = wgid / nig, fm = gid * WGM, gsz = (nM - fm) < WGM ? (nM - fm) : WGM;
        u.pm = fm + ((wgid % nig) % gsz); u.pn = (wgid % nig) / gsz; return true;
    }
};
typedef f32x4 Acc[2][2][4][2];

template <class Epi, int KMODE>
__device__ __forceinline__ void gemm_phase(LAS unsigned char* lds, const Gemm g, const StaticOrder& S, const Epi& E) {
    int tid = threadIdx.x; asm volatile("" : "+v"(tid));
    const int wid = __builtin_amdgcn_readfirstlane(tid >> 6), lane = tid & 63, wr = wid >> 2, wc = wid & 3, fr = lane & 15, fq = lane >> 4;
    const int nt = g.K / BK;
    unsigned voffA[2], voffB[2];
#pragma unroll
    for (int i = 0; i < 2; ++i) { int R, C; stage_rc(tid * 16 + i * 8192, R, C); const int Rb = Epi::PERM ? ((R & ~31) + perm32(R & 31)) : R;
        voffA[i] = (unsigned)(R * g.lda + C) * 2u; voffB[i] = (unsigned)(Rb * g.ldb + C) * 2u; }
    const size_t kstep = (size_t)(BK * 2);
    const size_t hstepA = (size_t)HALF * g.lda * 2, hstepB = (size_t)HALF * g.ldb * 2;
    const unsigned ldsw = (unsigned)wid * 1024u;
    const int aoff = lds_byte(wr * 64 + fr, fq * 8), boff = lds_byte(wc * 32 + fr, fq * 8);
#define TILE_A(pm) ((const char*)g.A + (KMODE ? ((size_t)(((pm) >> 4) * NH * SEQ + ((pm) & 15) * 256) * 512) : (size_t)(pm) * 2 * hstepA))
#define TILE_B(pn) ((const char*)g.Bt + (size_t)(pn) * 2 * hstepB)
#define KOFF_A(t) (KMODE ? ((size_t)((t) >> 2) * ((size_t)SEQ * 512) + (size_t)((t) & 3) * kstep) : (size_t)(t) * kstep)
#define PG8_SA(b, h) (((b) * 2 + (h)) * HTB)
#define PG8_SB(b, h) ((4 + (b) * 2 + (h)) * HTB)
#define PG8_STAGE(bufoff, gbase, voff) do { _Pragma("unroll") for (int _i = 0; _i < 2; ++_i) \
        __builtin_amdgcn_global_load_lds((const unsigned*)((const char*)(gbase) + (voff)[_i]), (LAS unsigned*)(lds + (bufoff) + ldsw + _i * 8192), 16, 0, 0); } while (0)
#define PG8_LDA(dst, b, h) do { _Pragma("unroll") for (int m = 0; m < 4; ++m) _Pragma("unroll") for (int k = 0; k < 2; ++k) dst[m][k] = *(const LAS bf16x8*)(lds + PG8_SA(b, h) + aoff + m * 2048 + k * 1024); } while (0)
#define PG8_LDB(dst, b, h) do { _Pragma("unroll") for (int n = 0; n < 2; ++n) _Pragma("unroll") for (int k = 0; k < 2; ++k) dst[n][k] = *(const LAS bf16x8*)(lds + PG8_SB(b, h) + boff + n * 2048 + k * 1024); } while (0)
#define PG8_MMA(ai, bj, At, Bt) do { __builtin_amdgcn_s_setprio(1); _Pragma("unroll") for (int m = 0; m < 4; ++m) _Pragma("unroll") for (int n = 0; n < 2; ++n) _Pragma("unroll") for (int k = 0; k < 2; ++k) \
        acc[ai][bj][m][n] = __builtin_amdgcn_mfma_f32_16x16x32_bf16(Bt[n][k], At[m][k], acc[ai][bj][m][n], 0, 0, 0); __builtin_amdgcn_s_setprio(0); } while (0)
#define PG8_WAIT_V(n) asm volatile("s_waitcnt vmcnt(" #n ")" ::: "memory")
#define PG8_WAIT_L(n) asm volatile("s_waitcnt lgkmcnt(" #n ")" ::: "memory")
#define PG8_BAR __builtin_amdgcn_s_barrier()
#define PG8_SCHED __builtin_amdgcn_sched_barrier(0)
    Unit cur, nxt; int ui = 0;
    if (!S.next(0, cur)) return;
    Acc acc;
#pragma unroll
    for (int a = 0; a < 2; ++a)
#pragma unroll
        for (int b = 0; b < 2; ++b)
#pragma unroll
            for (int m = 0; m < 4; ++m)
#pragma unroll
                for (int n = 0; n < 2; ++n) acc[a][b][m][n] = (f32x4){0.f, 0.f, 0.f, 0.f};
    bf16x8 At[4][2], B0[2][2], B1[2][2];
    const char* cA = TILE_A(cur.pm); const char* cB = TILE_B(cur.pn);
    {
        PG8_STAGE(PG8_SB(0, 0), cB, voffB); PG8_STAGE(PG8_SB(0, 1), cB + hstepB, voffB); PG8_STAGE(PG8_SA(0, 0), cA, voffA); PG8_STAGE(PG8_SA(0, 1), cA + hstepA, voffA);
        if (wr == 1) PG8_BAR;
        PG8_WAIT_V(2); PG8_BAR;
        PG8_STAGE(PG8_SB(1, 0), cB + kstep, voffB); PG8_STAGE(PG8_SA(1, 0), cA + KOFF_A(1), voffA); PG8_STAGE(PG8_SB(1, 1), cB + hstepB + kstep, voffB);
        PG8_WAIT_V(6); PG8_BAR;
    }
    for (;;) {
        const bool has_next = S.next(ui + 1, nxt);
        int tid_p = tid; asm volatile("" : "+v"(tid_p));
        const f32x4 pre = E.pre_load(cur, tid_p);
        const char* nA = has_next ? TILE_A(nxt.pm) : cA; const char* nB = has_next ? TILE_B(nxt.pn) : cB;
        for (int t = 0; t < nt; t += 2) {
            const bool last = (t == nt - 2);
            const char* a1 = cA + KOFF_A(t + 1);
            const char* a2 = last ? nA : cA + KOFF_A(t + 2); const char* b2 = last ? nB : cB + (size_t)(t + 2) * kstep;
            const char* a3 = last ? nA + KOFF_A(1) : cA + KOFF_A(t + 3); const char* b3 = b2 + kstep;
            PG8_LDB(B0, 0, 0); PG8_LDB(B1, 0, 1); PG8_SCHED; PG8_LDA(At, 0, 0); PG8_STAGE(PG8_SA(1, 1), a1 + hstepA, voffA);
            PG8_WAIT_V(8); PG8_WAIT_L(0); PG8_BAR; PG8_MMA(0, 0, At, B0); PG8_MMA(0, 1, At, B1); PG8_BAR; PG8_SCHED;
            PG8_LDA(At, 0, 1); PG8_STAGE(PG8_SB(0, 0), b2, voffB); PG8_STAGE(PG8_SB(0, 1), b2 + hstepB, voffB); PG8_STAGE(PG8_SA(0, 0), a2, voffA);
            PG8_WAIT_V(8); PG8_WAIT_L(0); PG8_BAR; PG8_MMA(1, 0, At, B0); PG8_MMA(1, 1, At, B1); PG8_BAR; PG8_SCHED;
            PG8_LDB(B0, 1, 0); PG8_LDB(B1, 1, 1); PG8_SCHED; PG8_LDA(At, 1, 0); PG8_STAGE(PG8_SA(0, 1), a2 + hstepA, voffA);
            PG8_WAIT_V(8); PG8_WAIT_L(0); PG8_BAR; PG8_MMA(0, 0, At, B0); PG8_MMA(0, 1, At, B1); PG8_BAR; PG8_SCHED;
            PG8_LDA(At, 1, 1); PG8_STAGE(PG8_SB(1, 0), b3, voffB); PG8_STAGE(PG8_SB(1, 1), b3 + hstepB, voffB); PG8_STAGE(PG8_SA(1, 0), a3, voffA);
            PG8_WAIT_V(8); PG8_WAIT_L(0); PG8_BAR; PG8_MMA(1, 0, At, B0); PG8_MMA(1, 1, At, B1); PG8_BAR; PG8_SCHED;
        }
        if (wr == 0) PG8_BAR;
        { int fr_e = fr, fq_e = fq, tid_e = tid; asm volatile("" : "+v"(fr_e), "+v"(fq_e), "+v"(tid_e));
          E(acc, cur, wr, wc, fr_e, fq_e, lds, tid_e, pre); }
        if (!has_next) break;
#pragma unroll
        for (int a = 0; a < 2; ++a)
#pragma unroll
            for (int b = 0; b < 2; ++b)
#pragma unroll
                for (int m = 0; m < 4; ++m)
#pragma unroll
                    for (int n = 0; n < 2; ++n) acc[a][b][m][n] = (f32x4){0.f, 0.f, 0.f, 0.f};
        cur = nxt; cA = nA; cB = nB; ++ui;
        if (wr == 1) PG8_BAR;
    }
    PG8_WAIT_V(0);
    PG8_BAR;
#undef TILE_A
#undef TILE_B
#undef KOFF_A
#undef PG8_SA
#undef PG8_SB
#undef PG8_STAGE
#undef PG8_LDA
#undef PG8_LDB
#undef PG8_MMA
#undef PG8_WAIT_V
#undef PG8_WAIT_L
#undef PG8_BAR
#undef PG8_SCHED
}

#define EPI_ARGS const Acc& acc, const Unit& u, int wr, int wc, int fr, int fq, LAS unsigned char* lds, int tid, const f32x4 pre
#define EPI_NOPRE __device__ __forceinline__ f32x4 pre_load(const Unit&, int) const { return (f32x4){0.f, 0.f, 0.f, 0.f}; }
constexpr int LDS_TAB = 131072;
#define EPI_BARRIER() do { asm volatile("s_waitcnt lgkmcnt(0)" ::: "memory"); __builtin_amdgcn_s_barrier(); asm volatile("" ::: "memory"); } while (0)
__device__ __forceinline__ f32x4 ln_pre(const f32x2* statp, int row_base, int tid) { return *(const f32x4*)(statp + (size_t)(row_base + (tid >> 1)) * 4 + 2 * (tid & 1)); }
__device__ __forceinline__ void ln_table(LAS unsigned char* lds, const f32x4 v, int tid) {
    LAS f32x2* S = (LAS f32x2*)(lds + LDS_TAB);
    const int r = tid >> 1, hf = tid & 1;
    float s = v[0] + v[2], q = v[1] + v[3];
    s += __shfl_xor(s, 1); q += __shfl_xor(q, 1);
    const float mean = s * (1.f / DM), var = fmaxf(q * (1.f / DM) - mean * mean, 0.f);
    if (hf == 0) S[r] = (f32x2){mean, 1.0f / sqrtf(var + LN_EPS)};
    EPI_BARRIER();
}
#define LNX(a, c1v, c2v) (((a) - (c1v) * mu) * rs + (c2v))
template <bool LN> struct EpiGU { static constexpr bool PERM = true; bf16_t* H; const f32x2* statp; const float* c1; const float* c2;
    __device__ __forceinline__ f32x4 pre_load(const Unit& u, int tid) const { return LN ? ln_pre(statp, u.pm * 256, tid) : (f32x4){0.f, 0.f, 0.f, 0.f}; }
    __device__ __forceinline__ void operator()(EPI_ARGS) const {
        const int i0 = wc * 32 + fq * 8, c0 = u.pn * 128 + i0;
        f32x4 g1a, g1b, u1a, u1b, g2a, g2b, u2a, u2b;
        if (LN) { ln_table(lds, pre, tid); const float* p1 = c1 + u.pn * 256 + i0; const float* p2 = c2 + u.pn * 256 + i0;
            g1a = *(const f32x4*)p1; g1b = *(const f32x4*)(p1 + 4); u1a = *(const f32x4*)(p1 + 128); u1b = *(const f32x4*)(p1 + 132);
            g2a = *(const f32x4*)p2; g2b = *(const f32x4*)(p2 + 4); u2a = *(const f32x4*)(p2 + 128); u2b = *(const f32x4*)(p2 + 132); }
        const LAS f32x2* S = (const LAS f32x2*)(lds + LDS_TAB);
#pragma unroll
        for (int ai = 0; ai < 2; ++ai)
#pragma unroll
            for (int m = 0; m < 4; ++m) { const int rl = ai * 128 + wr * 64 + m * 16 + fr, row = u.pm * 256 + rl;
                f32x4 ga = acc[ai][0][m][0], gb = acc[ai][0][m][1], ua = acc[ai][1][m][0], ub = acc[ai][1][m][1];
                if (LN) { const f32x2 st = S[rl]; const float mu = st[0], rs = st[1]; ga = LNX(ga, g1a, g2a); gb = LNX(gb, g1b, g2b); ua = LNX(ua, u1a, u2a); ub = LNX(ub, u1b, u2b); }
                f32x4 h0, h1;
#pragma unroll
                for (int j = 0; j < 4; ++j) { h0[j] = siluf_(ga[j]) * ua[j]; h1[j] = siluf_(gb[j]) * ub[j]; }
                *(u32x4*)(H + (size_t)row * DFF + c0) = pack8(h0, h1); }
    } };
template <int MODE> struct EpiResLn { static constexpr bool PERM = true; const float* X; bf16_t* Tb; f32x2* statp; const f32x2* statp_prev; const float* g; const float* b; float scale;
    __device__ __forceinline__ f32x4 pre_load(const Unit& u, int tid) const { return MODE == 1 ? ln_pre(statp_prev, u.pm * 256, tid) : (f32x4){0.f, 0.f, 0.f, 0.f}; }
    __device__ __forceinline__ void operator()(EPI_ARGS) const {
        if (MODE == 1) ln_table(lds, pre, tid);
        const LAS f32x2* S = (const LAS f32x2*)(lds + LDS_TAB); LAS f32x2* P = (LAS f32x2*)(lds + LDS_TAB + 2048);
        const int cb = u.pn * 256 + wc * 32 + fq * 8;
        f32x4 gg[2][2], bb[2][2];
        if (MODE == 1) {
#pragma unroll
            for (int bj = 0; bj < 2; ++bj)
#pragma unroll
                for (int n = 0; n < 2; ++n) { gg[bj][n] = *(const f32x4*)(g + cb + bj * 128 + n * 4); bb[bj][n] = *(const f32x4*)(b + cb + bj * 128 + n * 4); } }
#pragma unroll
        for (int ai = 0; ai < 2; ++ai) { f32x4 src[4][2][2]; u32x2 srb[4][2][2];
#pragma unroll
                for (int m = 0; m < 4; ++m)
#pragma unroll
                    for (int bj = 0; bj < 2; ++bj)
#pragma unroll
                        for (int n = 0; n < 2; ++n) { const size_t o = (size_t)(u.pm * 256 + ai * 128 + wr * 64 + m * 16 + fr) * DM + cb + bj * 128 + n * 4;
                            if (MODE == 0) src[m][bj][n] = *(const f32x4*)(X + o); else srb[m][bj][n] = *(const u32x2*)(Tb + o); }
                asm volatile("" ::: "memory");
#pragma unroll
                for (int m = 0; m < 4; ++m) { const int rl = ai * 128 + wr * 64 + m * 16 + fr, row = u.pm * 256 + rl; float mu = 0.f, rs = 0.f;
                    if (MODE == 1) { const f32x2 st = S[rl]; mu = st[0]; rs = st[1]; }
                    float sm = 0.f, q = 0.f;
#pragma unroll
                    for (int bj = 0; bj < 2; ++bj)
#pragma unroll
                        for (int n = 0; n < 2; ++n) { const size_t o = (size_t)row * DM + cb + bj * 128 + n * 4; f32x4 res;
                            if (MODE == 0) res = src[m][bj][n];
                            else { const u32x2 w = srb[m][bj][n]; const f32x4 t = {bf_lo(w.x), bf_hi(w.x), bf_lo(w.y), bf_hi(w.y)}; res = (t - mu) * rs * gg[bj][n] + bb[bj][n]; }
                            const f32x4 v = res * ALPHA + acc[ai][bj][m][n] * scale;
                            { u32x2 w; w.x = cvt_pk_bf16(v[0], v[1]); w.y = cvt_pk_bf16(v[2], v[3]); *(u32x2*)(Tb + o) = w; }
                            sm += (v[0] + v[1]) + (v[2] + v[3]); q += (v[0] * v[0] + v[1] * v[1]) + (v[2] * v[2] + v[3] * v[3]); }
                    sm += __shfl_xor(sm, 16); q += __shfl_xor(q, 16); sm += __shfl_xor(sm, 32); q += __shfl_xor(q, 32); if (fq == 0) P[rl * 4 + wc] = (f32x2){sm, q}; }
                asm volatile("" ::: "memory"); }
        EPI_BARRIER();
        if (tid < 256) { const f32x2 a0 = P[tid * 4], a1 = P[tid * 4 + 1], a2 = P[tid * 4 + 2], a3 = P[tid * 4 + 3]; statp[(size_t)(u.pm * 256 + tid) * 4 + u.pn] = (f32x2){(a0[0] + a1[0]) + (a2[0] + a3[0]), (a0[1] + a1[1]) + (a2[1] + a3[1])}; }
    } };
struct EpiQK { static constexpr bool PERM = true; bf16_t* Q; bf16_t* Kk; const f32x2* statp; const float* c1; const float* c2;
    __device__ __forceinline__ f32x4 pre_load(const Unit& u, int tid) const { return ln_pre(statp, u.pm * 256, tid); }
    __device__ __forceinline__ void operator()(EPI_ARGS) const {
        ln_table(lds, pre, tid); const LAS f32x2* S = (const LAS f32x2*)(lds + LDS_TAB);
        const bool isK = u.pn >= 4; const int t4 = u.pn & 3; bf16_t* dst = isK ? Kk : Q; const float QS = QSCALE;
        const int i0 = wc * 32 + fq * 8, head = 2 * t4 + (i0 >> 6), dlo = i0 & 63; const float lgk = log2gamma(head);
        const float* p1 = c1 + u.pn * 256 + i0; const float* p2 = c2 + u.pn * 256 + i0;
        const f32x4 k1a = *(const f32x4*)(p1), k1b = *(const f32x4*)(p1 + 4), k2a = *(const f32x4*)(p1 + 128), k2b = *(const f32x4*)(p1 + 132);
        const f32x4 b1a = *(const f32x4*)(p2), b1b = *(const f32x4*)(p2 + 4), b2a = *(const f32x4*)(p2 + 128), b2b = *(const f32x4*)(p2 + 132);
        f32x4 fa, fb;
#pragma unroll
        for (int j = 0; j < 4; ++j) { fa[j] = exp2f(-(float)(dlo + j) * 0.20762050593046014f) * 0.15915494309189535f; fb[j] = exp2f(-(float)(dlo + 4 + j) * 0.20762050593046014f) * 0.15915494309189535f; }
#pragma unroll
        for (int ai = 0; ai < 2; ++ai)
#pragma unroll
            for (int m = 0; m < 4; ++m) { const int rl = ai * 128 + wr * 64 + m * 16 + fr, row = u.pm * 256 + rl; const int s = row & (SEQ - 1), b = row >> 12;
                const f32x2 st = S[rl]; const float mu = st[0], rs = st[1]; const float sf = (float)s;
                f32x4 ca, cb, sa, sb;
#pragma unroll
                for (int j = 0; j < 4; ++j) { const float ra = __builtin_amdgcn_fractf(sf * fa[j]), rb = __builtin_amdgcn_fractf(sf * fb[j]);
                    ca[j] = __builtin_amdgcn_cosf(ra); sa[j] = __builtin_amdgcn_sinf(ra); cb[j] = __builtin_amdgcn_cosf(rb); sb[j] = __builtin_amdgcn_sinf(rb); }
                const f32x4 x1a = LNX(acc[ai][0][m][0], k1a, b1a), x1b = LNX(acc[ai][0][m][1], k1b, b1b), x2a = LNX(acc[ai][1][m][0], k2a, b2a), x2b = LNX(acc[ai][1][m][1], k2b, b2b);
                const float sc = isK ? exp2f((float)(127 - (s & 127)) * lgk) : QS;
                const f32x4 o1a = (x1a * ca - x2a * sa) * sc, o1b = (x1b * cb - x2b * sb) * sc, o2a = (x2a * ca + x1a * sa) * sc, o2b = (x2b * cb + x1b * sb) * sc;
                bf16_t* base = dst + ((size_t)((b * NH + head) * SEQ + s)) * DK + dlo;
                *(u32x4*)(base) = pack8(o1a, o1b); *(u32x4*)(base + 64) = pack8(o2a, o2b); }
    } };
struct EpiVT { static constexpr bool PERM = true; bf16_t* VT; const f32x2* statp; const float* c1; const float* c2;
    __device__ __forceinline__ f32x4 pre_load(const Unit& u, int tid) const { return ln_pre(statp, u.pn * 256, tid); }
    __device__ __forceinline__ void operator()(EPI_ARGS) const {
        ln_table(lds, pre, tid); const LAS f32x4* S4 = (const LAS f32x4*)(lds + LDS_TAB);
        float kk[2][4], bi[2][4];
#pragma unroll
        for (int ai = 0; ai < 2; ++ai)
#pragma unroll
            for (int m = 0; m < 4; ++m) { const int r = u.pm * 256 + ai * 128 + wr * 64 + m * 16 + fr; kk[ai][m] = c1[r]; bi[ai][m] = c2[r]; }
        asm volatile("" ::: "memory");
#pragma unroll
        for (int bj = 0; bj < 2; ++bj) { const int tl = bj * 128 + wc * 32 + fq * 8, tok0 = u.pn * 256 + tl; const int s0 = tok0 & (SEQ - 1), b = tok0 >> 12;
            const f32x4 t01 = S4[tl / 2], t23 = S4[tl / 2 + 1], t45 = S4[tl / 2 + 2], t67 = S4[tl / 2 + 3];
            const f32x4 mua = {t01[0], t01[2], t23[0], t23[2]}, rsa = {t01[1], t01[3], t23[1], t23[3]}, mub = {t45[0], t45[2], t67[0], t67[2]}, rsb = {t45[1], t45[3], t67[1], t67[3]};
            const int nch = s0 >> 7, j0 = s0 & 127, ks = j0 >> 4, lhh = (j0 >> 3) & 1;
#pragma unroll
            for (int ai = 0; ai < 2; ++ai)
#pragma unroll
                for (int m = 0; m < 4; ++m) { const int r = u.pm * 256 + ai * 128 + wr * 64 + m * 16 + fr; const float k1 = kk[ai][m], bv = bi[ai][m]; const int e = r & 255;
                    *(u32x4*)(VT + ((((size_t)((b * NH + u.pm) * 32 + nch) * 8 + (e >> 5)) * 8 + ks) * 64 + lhh * 32 + (e & 31)) * 8) = pack8((acc[ai][bj][m][0] - mua * k1) * rsa + bv, (acc[ai][bj][m][1] - mub * k1) * rsb + bv); } }
    } };
struct EpiG { static constexpr bool PERM = true; bf16_t* RN; const f32x2* statp; const float* c1; const float* c2;
    __device__ __forceinline__ f32x4 pre_load(const Unit& u, int tid) const { return ln_pre(statp, u.pm * 256, tid); }
    __device__ __forceinline__ void operator()(EPI_ARGS) const {
        ln_table(lds, pre, tid); const LAS f32x2* S = (const LAS f32x2*)(lds + LDS_TAB);
#pragma unroll
        for (int bj = 0; bj < 2; ++bj) { const int e0 = bj * 128 + wc * 32 + fq * 8; const float* p1 = c1 + u.pn * 256 + e0; const float* p2 = c2 + u.pn * 256 + e0;
            const f32x4 ka = *(const f32x4*)p1, kb = *(const f32x4*)(p1 + 4), ba = *(const f32x4*)p2, bb = *(const f32x4*)(p2 + 4);
            u32x4 rn[2][4];
#pragma unroll
            for (int ai = 0; ai < 2; ++ai)
#pragma unroll
                for (int m = 0; m < 4; ++m) { const int row = u.pm * 256 + ai * 128 + wr * 64 + m * 16 + fr; rn[ai][m] = *(const u32x4*)(RN + ((size_t)(((row >> 12) * NH + u.pn) * SEQ + (row & (SEQ - 1)))) * DV + e0); }
            asm volatile("" ::: "memory");
#pragma unroll
            for (int ai = 0; ai < 2; ++ai)
#pragma unroll
                for (int m = 0; m < 4; ++m) { const int rl = ai * 128 + wr * 64 + m * 16 + fr, row = u.pm * 256 + rl; const int s = row & (SEQ - 1), b = row >> 12;
                    const f32x2 st = S[rl]; const float mu = st[0], rs = st[1];
                    bf16_t* p = RN + ((size_t)((b * NH + u.pn) * SEQ + s)) * DV + e0; f32x4 ra, rb; unpack8(rn[ai][m], ra, rb);
                    f32x4 ga = LNX(acc[ai][bj][m][0], ka, ba), gb = LNX(acc[ai][bj][m][1], kb, bb);
#pragma unroll
                    for (int j = 0; j < 4; ++j) { ga[j] = siluf_(ga[j]) * ra[j]; gb[j] = siluf_(gb[j]) * rb[j]; }
                    *(u32x4*)p = pack8(ga, gb); }
            asm volatile("" ::: "memory"); }
    } };
struct EpiU { static constexpr bool PERM = true; bf16_t* U; const f32x2* statp; const float* c1; const float* c2;
    __device__ __forceinline__ f32x4 pre_load(const Unit& u, int tid) const { return ln_pre(statp, u.pm * 256, tid); }
    __device__ __forceinline__ void operator()(EPI_ARGS) const {
        ln_table(lds, pre, tid); const LAS f32x2* S = (const LAS f32x2*)(lds + LDS_TAB);
        const int i0 = wc * 32 + fq * 8; const float* p1 = c1 + u.pn * 256 + i0; const float* p2 = c2 + u.pn * 256 + i0;
        const f32x4 k1a = *(const f32x4*)(p1), k1b = *(const f32x4*)(p1 + 4), k2a = *(const f32x4*)(p1 + 128), k2b = *(const f32x4*)(p1 + 132);
        const f32x4 b1a = *(const f32x4*)(p2), b1b = *(const f32x4*)(p2 + 4), b2a = *(const f32x4*)(p2 + 128), b2b = *(const f32x4*)(p2 + 132);
#pragma unroll
        for (int ai = 0; ai < 2; ++ai)
#pragma unroll
            for (int m = 0; m < 4; ++m) { const int rl = ai * 128 + wr * 64 + m * 16 + fr, row = u.pm * 256 + rl; const f32x2 st = S[rl]; const float mu = st[0], rs = st[1];
                f32x4 xa = LNX(acc[ai][0][m][0], k1a, b1a), xb = LNX(acc[ai][0][m][1], k1b, b1b); const f32x4 ya = LNX(acc[ai][1][m][0], k2a, b2a), yb = LNX(acc[ai][1][m][1], k2b, b2b);
#pragma unroll
                for (int j = 0; j < 4; ++j) { xa[j] *= sigmoidf_(ya[j]); xb[j] *= sigmoidf_(yb[j]); }
                *(u32x4*)(U + (size_t)row * DM + u.pn * 128 + i0) = pack8(xa, xb); }
    } };
struct EpiGates { static constexpr bool PERM = true; bf16_t* GR; bf16_t* GC; const f32x2* statp; const float* c1; const float* c2;
    __device__ __forceinline__ f32x4 pre_load(const Unit& u, int tid) const { return ln_pre(statp, u.pm * 256, tid); }
    __device__ __forceinline__ void operator()(EPI_ARGS) const {
        ln_table(lds, pre, tid); const LAS f32x2* S = (const LAS f32x2*)(lds + LDS_TAB);
        bf16_t* dst = u.pn < 4 ? GR : GC;
        f32x4 kv[2][2], bv[2][2];
#pragma unroll
        for (int bj = 0; bj < 2; ++bj) { const int c0 = u.pn * 256 + bj * 128 + wc * 32 + fq * 8; kv[bj][0] = *(const f32x4*)(c1 + c0); kv[bj][1] = *(const f32x4*)(c1 + c0 + 4); bv[bj][0] = *(const f32x4*)(c2 + c0); bv[bj][1] = *(const f32x4*)(c2 + c0 + 4); }
        asm volatile("" ::: "memory");
#pragma unroll
        for (int bj = 0; bj < 2; ++bj) { const int c0 = u.pn * 256 + bj * 128 + wc * 32 + fq * 8;
#pragma unroll
            for (int ai = 0; ai < 2; ++ai)
#pragma unroll
                for (int m = 0; m < 4; ++m) { const int rl = ai * 128 + wr * 64 + m * 16 + fr, row = u.pm * 256 + rl; const f32x2 st = S[rl]; const float mu = st[0], rs = st[1];
                    f32x4 ga = LNX(acc[ai][bj][m][0], kv[bj][0], bv[bj][0]), gb = LNX(acc[ai][bj][m][1], kv[bj][1], bv[bj][1]);
#pragma unroll
                    for (int j = 0; j < 4; ++j) { ga[j] = sigmoidf_(ga[j]); gb[j] = sigmoidf_(gb[j]); }
                    *(u32x4*)(dst + (size_t)row * DM + (c0 & 1023)) = pack8(ga, gb); } }
    } };
struct EpiRO { static constexpr bool PERM = true; const bf16_t* GR; bf16_t* T1; EPI_NOPRE
    __device__ __forceinline__ void operator()(EPI_ARGS) const {
#pragma unroll
        for (int ai = 0; ai < 2; ++ai) { u32x4 gr[4][2];
#pragma unroll
            for (int m = 0; m < 4; ++m)
#pragma unroll
                for (int bj = 0; bj < 2; ++bj) gr[m][bj] = *(const u32x4*)(GR + (size_t)(u.pm * 256 + ai * 128 + wr * 64 + m * 16 + fr) * DM + u.pn * 256 + bj * 128 + wc * 32 + fq * 8);
            asm volatile("" ::: "memory");
#pragma unroll
            for (int m = 0; m < 4; ++m)
#pragma unroll
                for (int bj = 0; bj < 2; ++bj) { const size_t o = (size_t)(u.pm * 256 + ai * 128 + wr * 64 + m * 16 + fr) * DM + u.pn * 256 + bj * 128 + wc * 32 + fq * 8; f32x4 ga, gb; unpack8(gr[m][bj], ga, gb);
                    *(u32x4*)(T1 + o) = pack8(ga * acc[ai][bj][m][0], gb * acc[ai][bj][m][1]); }
            asm volatile("" ::: "memory"); }
    } };
struct EpiCO { static constexpr bool PERM = true; const bf16_t* GC; const bf16_t* T1; bf16_t* MG; EPI_NOPRE
    __device__ __forceinline__ void operator()(EPI_ARGS) const {
#pragma unroll
        for (int ai = 0; ai < 2; ++ai) { u32x4 gc[4][2], t1[4][2];
#pragma unroll
            for (int m = 0; m < 4; ++m)
#pragma unroll
                for (int bj = 0; bj < 2; ++bj) { const size_t o = (size_t)(u.pm * 256 + ai * 128 + wr * 64 + m * 16 + fr) * DM + u.pn * 256 + bj * 128 + wc * 32 + fq * 8;
                    gc[m][bj] = *(const u32x4*)(GC + o); t1[m][bj] = *(const u32x4*)(T1 + o); }
            asm volatile("" ::: "memory");
#pragma unroll
            for (int m = 0; m < 4; ++m)
#pragma unroll
                for (int bj = 0; bj < 2; ++bj) { const size_t o = (size_t)(u.pm * 256 + ai * 128 + wr * 64 + m * 16 + fr) * DM + u.pn * 256 + bj * 128 + wc * 32 + fq * 8; f32x4 ga, gb, ta, tb; unpack8(gc[m][bj], ga, gb); unpack8(t1[m][bj], ta, tb);
                    *(u32x4*)(MG + o) = pack8(ta + ga * acc[ai][bj][m][0], tb + gb * acc[ai][bj][m][1]); }
            asm volatile("" ::: "memory"); }
    } };
struct EpiFinalLn { static constexpr bool PERM = true; float* Out; const bf16_t* Tsrc; const f32x2* statp_prev; const float* g; const float* b; float scale; unsigned long long* xbuf; unsigned* cnt; const float* g3; const float* b3;
    __device__ __forceinline__ f32x4 pre_load(const Unit& u, int tid) const { return ln_pre(statp_prev, u.pm * 256, tid); }
    __device__ __forceinline__ void operator()(EPI_ARGS) const {
        Acc& a = const_cast<Acc&>(acc);
        ln_table(lds, pre, tid);
        LAS f32x2* S = (LAS f32x2*)(lds + LDS_TAB); LAS f32x2* P = (LAS f32x2*)(lds + LDS_TAB + 2048);
        const int cb = u.pn * 256 + wc * 32 + fq * 8;
        { f32x4 gg[2][2], bb[2][2];
#pragma unroll
          for (int bj = 0; bj < 2; ++bj)
#pragma unroll
            for (int n = 0; n < 2; ++n) { gg[bj][n] = *(const f32x4*)(g + cb + bj * 128 + n * 4); bb[bj][n] = *(const f32x4*)(b + cb + bj * 128 + n * 4); }
#pragma unroll
          for (int ai = 0; ai < 2; ++ai) { u32x2 srb[4][2][2];
#pragma unroll
                for (int m = 0; m < 4; ++m)
#pragma unroll
                    for (int bj = 0; bj < 2; ++bj)
#pragma unroll
                        for (int n = 0; n < 2; ++n) srb[m][bj][n] = *(const u32x2*)(Tsrc + (size_t)(u.pm * 256 + ai * 128 + wr * 64 + m * 16 + fr) * DM + cb + bj * 128 + n * 4);
                asm volatile("" ::: "memory");
#pragma unroll
                for (int m = 0; m < 4; ++m) { const int rl = ai * 128 + wr * 64 + m * 16 + fr; const f32x2 st = S[rl]; const float mu = st[0], rs = st[1];
                    float sm = 0.f, q = 0.f;
#pragma unroll
                    for (int bj = 0; bj < 2; ++bj)
#pragma unroll
                        for (int n = 0; n < 2; ++n) { const u32x2 w = srb[m][bj][n]; const f32x4 t = {bf_lo(w.x), bf_hi(w.x), bf_lo(w.y), bf_hi(w.y)};
                            const f32x4 res = (t - mu) * rs * gg[bj][n] + bb[bj][n]; const f32x4 v = res * ALPHA + a[ai][bj][m][n] * scale; a[ai][bj][m][n] = v;
                            sm += (v[0] + v[1]) + (v[2] + v[3]); q += (v[0] * v[0] + v[1] * v[1]) + (v[2] * v[2] + v[3] * v[3]); }
                    sm += __shfl_xor(sm, 16); q += __shfl_xor(q, 16); sm += __shfl_xor(sm, 32); q += __shfl_xor(q, 32); if (fq == 0) P[rl * 4 + wc] = (f32x2){sm, q}; }
                asm volatile("" ::: "memory"); } }
        EPI_BARRIER();
        if (tid < 256) { const f32x2 a0 = P[tid * 4], a1 = P[tid * 4 + 1], a2 = P[tid * 4 + 2], a3 = P[tid * 4 + 3]; const float ssum = (a0[0] + a1[0]) + (a2[0] + a3[0]), qsum = (a0[1] + a1[1]) + (a2[1] + a3[1]);
            __hip_atomic_store(xbuf + (size_t)(u.pm * 256 + tid) * 4 + u.pn, ((unsigned long long)__float_as_uint(qsum) << 32) | __float_as_uint(ssum), __ATOMIC_RELAXED, __HIP_MEMORY_SCOPE_AGENT); }
        asm volatile("s_waitcnt vmcnt(0)" ::: "memory");
        if (tid < 256 && (tid & 63) == 0) __hip_atomic_fetch_add(cnt + 64 * u.pm, 1u, __ATOMIC_RELAXED, __HIP_MEMORY_SCOPE_AGENT);
        if (tid < 64) { unsigned sp = 0;
            while ((unsigned)__builtin_amdgcn_readfirstlane(__hip_atomic_load(cnt + 64 * u.pm, __ATOMIC_RELAXED, __HIP_MEMORY_SCOPE_AGENT)) < 16u) { __builtin_amdgcn_s_sleep(1); if (++sp > (1u << 20)) break; }
            __builtin_amdgcn_fence(__ATOMIC_ACQUIRE, "agent"); asm volatile("s_waitcnt vmcnt(0)" ::: "memory"); }
        EPI_BARRIER();
        { const int r = tid >> 1, hf = tid & 1; const unsigned long long* sl = xbuf + (size_t)(u.pm * 256 + r) * 4 + 2 * hf;
          const unsigned long long w0 = __hip_atomic_load(sl, __ATOMIC_RELAXED, __HIP_MEMORY_SCOPE_AGENT), w1 = __hip_atomic_load(sl + 1, __ATOMIC_RELAXED, __HIP_MEMORY_SCOPE_AGENT);
          float sm = __uint_as_float((unsigned)w0) + __uint_as_float((unsigned)w1), q = __uint_as_float((unsigned)(w0 >> 32)) + __uint_as_float((unsigned)(w1 >> 32));
          sm += __shfl_xor(sm, 1); q += __shfl_xor(q, 1);
          const float mean = sm * (1.f / DM), var = fmaxf(q * (1.f / DM) - mean * mean, 0.f);
          if (hf == 0) S[r] = (f32x2){mean, 1.0f / sqrtf(var + LN_EPS)}; }
        EPI_BARRIER();
        { f32x4 g4[2][2], b4[2][2];
#pragma unroll
          for (int bj = 0; bj < 2; ++bj)
#pragma unroll
            for (int n = 0; n < 2; ++n) { g4[bj][n] = *(const f32x4*)(g3 + cb + bj * 128 + n * 4); b4[bj][n] = *(const f32x4*)(b3 + cb + bj * 128 + n * 4); }
          asm volatile("" ::: "memory");
#pragma unroll
          for (int ai = 0; ai < 2; ++ai)
#pragma unroll
            for (int m = 0; m < 4; ++m) { const int rl = ai * 128 + wr * 64 + m * 16 + fr; const f32x2 st = S[rl]; const float mu = st[0], rs = st[1];
#pragma unroll
                for (int bj = 0; bj < 2; ++bj)
#pragma unroll
                    for (int n = 0; n < 2; ++n) *(f32x4*)(Out + (size_t)(u.pm * 256 + rl) * DM + cb + bj * 128 + n * 4) = (a[ai][bj][m][n] - mu) * rs * g4[bj][n] + b4[bj][n]; } }
    } };
struct EpiGUG { static constexpr bool PERM = true; EpiG eg; EpiU eu; EpiGates et;
    __device__ __forceinline__ f32x4 pre_load(const Unit& u, int tid) const { return ln_pre(eg.statp, u.pm * 256, tid); }
    __device__ __forceinline__ void operator()(EPI_ARGS) const {
        Unit v = u;
        if (u.pn < 8) eg(acc, v, wr, wc, fr, fq, lds, tid, pre);
        else if (u.pn < 16) { v.pn = u.pn - 8; eu(acc, v, wr, wc, fr, fq, lds, tid, pre); }
        else { v.pn = u.pn - 16; et(acc, v, wr, wc, fr, fq, lds, tid, pre); }
    } };
}

#ifndef REP_P0
#define REP_P0 1
#endif
#ifndef REP_LN
#define REP_LN 1
#endif
#ifndef REP_R1
#define REP_R1 1
#endif
#ifndef REP_CONV
#define REP_CONV 1
#endif
struct Params {
    const float* in[23];
    float* out;
    unsigned char* ws;
};

__device__ __forceinline__ int win_src_col(int n) {
    if (n < 2048) { const int base = n & 1024, r = n & 1023, t = r >> 8, p = r & 255, bj = p >> 7, i = p & 127; return base + (2 * t + (i >> 6)) * 128 + (i & 63) + 64 * bj; }
    if (n < 6144) return n;
    if (n < 8192) { const int r = n - 6144, t = r >> 8, p = r & 255; return p < 128 ? 6144 + 128 * t + p : 7168 + 128 * t + (p - 128); }
    return n;
}
__device__ __forceinline__ void transpose_item(const float* Wsrc  , int ldw, int K, bf16_t* WTrow  , int k0, LAS float* scr, int lane,
                                               const float* gk = nullptr, const float* bk = nullptr, float* c1 = nullptr, float* c2 = nullptr, const float* bias_src = nullptr) {
    { f32x4 wv[8];
      const float* wp = Wsrc + (size_t)(k0 + (lane >> 3)) * ldw + 4 * (lane & 7);
#pragma unroll
      for (int i = 0; i < 8; ++i) wv[i] = *(const f32x4*)(wp + (size_t)(8 * i) * ldw);
#pragma unroll
      for (int i = 0; i < 8; ++i)
#pragma unroll
          for (int t = 0; t < 4; ++t) scr[(8 * i + (lane >> 3)) * 33 + 4 * (lane & 7) + t] = wv[i][t]; }
    asm volatile("s_waitcnt lgkmcnt(0)" ::: "memory");
    if (gk) {
        const int n = lane & 31, kh = lane >> 5; float a1 = 0.f, a2 = 0.f;
        f32x4 g4v[8], b4v[8];
#pragma unroll
        for (int i = 0; i < 8; ++i) { g4v[i] = *(const f32x4*)(gk + k0 + kh * 32 + 4 * i); b4v[i] = *(const f32x4*)(bk + k0 + kh * 32 + 4 * i); }
#pragma unroll
        for (int kk = 0; kk < 32; ++kk) { const int k = kh * 32 + kk; const float w = scr[k * 33 + n]; a1 += bf_lo(cvt_pk_bf16(w * g4v[kk >> 2][kk & 3], 0.f)); a2 += b4v[kk >> 2][kk & 3] * w; }
        a1 += __shfl_xor(a1, 32); a2 += __shfl_xor(a2, 32);
        if (lane < 32) { if (k0 == 0 && bias_src) a2 += bias_src[n]; atomicAdd(c1 + n, a1); atomicAdd(c2 + n, a2); }
    }
    const int c = lane & 7;
    float gs[8];
    { f32x4 ga = {1.f, 1.f, 1.f, 1.f}, gb = ga; if (gk) { ga = *(const f32x4*)(gk + k0 + 8 * c); gb = *(const f32x4*)(gk + k0 + 8 * c + 4); }
#pragma unroll
      for (int j = 0; j < 4; ++j) { gs[j] = ga[j]; gs[4 + j] = gb[j]; } }
#pragma unroll
    for (int j = 0; j < 4; ++j) { const int n = (lane >> 3) + 8 * j; const LAS float* sp = scr + (8 * c) * 33 + n;
        u32x4 o; o.x = cvt_pk_bf16(sp[0 * 33] * gs[0], sp[1 * 33] * gs[1]); o.y = cvt_pk_bf16(sp[2 * 33] * gs[2], sp[3 * 33] * gs[3]); o.z = cvt_pk_bf16(sp[4 * 33] * gs[4], sp[5 * 33] * gs[5]); o.w = cvt_pk_bf16(sp[6 * 33] * gs[6], sp[7 * 33] * gs[7]);
        *(u32x4*)(WTrow + (size_t)n * K + k0 + 8 * c) = o; }
    asm volatile("s_waitcnt lgkmcnt(0)" ::: "memory");
}

__device__ __forceinline__ void ln_pass(const float* T, const float* g, const float* bta, float* Xf, bf16_t* Xb, int gw, int NGW, int lane) {
    f32x4 gv[4], bv[4];
#pragma unroll
    for (int j = 0; j < 4; ++j) { gv[j] = *(const f32x4*)(g + 4 * lane + 256 * j); bv[j] = *(const f32x4*)(bta + 4 * lane + 256 * j); }
    for (int row = gw; row < MTOK; row += 2 * NGW) {
        const int row2 = row + NGW;
        const bool has2 = row2 < MTOK;
        const float* tr = T + (size_t)row * DM + 4 * lane; const float* tr2 = T + (size_t)(has2 ? row2 : row) * DM + 4 * lane;
        f32x4 v[4], u[4]; float s = 0.f, q = 0.f, s_2 = 0.f, q_2 = 0.f;
#pragma unroll
        for (int j = 0; j < 4; ++j) { v[j] = *(const f32x4*)(tr + 256 * j); u[j] = *(const f32x4*)(tr2 + 256 * j); }
#pragma unroll
        for (int j = 0; j < 4; ++j) { s += (v[j][0] + v[j][1]) + (v[j][2] + v[j][3]); q += (v[j][0] * v[j][0] + v[j][1] * v[j][1]) + (v[j][2] * v[j][2] + v[j][3] * v[j][3]);
            s_2 += (u[j][0] + u[j][1]) + (u[j][2] + u[j][3]); q_2 += (u[j][0] * u[j][0] + u[j][1] * u[j][1]) + (u[j][2] * u[j][2] + u[j][3] * u[j][3]); }
        wave_sum2(s, q); wave_sum2(s_2, q_2);
        const float mean = s * (1.f / DM), rstd = 1.0f / sqrtf(fmaxf(q * (1.f / DM) - mean * mean, 0.f) + LN_EPS);
        const float mean2 = s_2 * (1.f / DM), rstd2 = 1.0f / sqrtf(fmaxf(q_2 * (1.f / DM) - mean2 * mean2, 0.f) + LN_EPS);
#pragma unroll
        for (int j = 0; j < 4; ++j) { const f32x4 y = (v[j] - mean) * rstd * gv[j] + bv[j]; *(f32x4*)(Xf + (size_t)row * DM + 4 * lane + 256 * j) = y;
            if (Xb) { u32x2 w; w.x = cvt_pk_bf16(y[0], y[1]); w.y = cvt_pk_bf16(y[2], y[3]); *(u32x2*)(Xb + (size_t)row * DM + 4 * lane + 256 * j) = w; } }
        if (has2) {
#pragma unroll
            for (int j = 0; j < 4; ++j) { const f32x4 y = (u[j] - mean2) * rstd2 * gv[j] + bv[j]; *(f32x4*)(Xf + (size_t)row2 * DM + 4 * lane + 256 * j) = y;
                if (Xb) { u32x2 w; w.x = cvt_pk_bf16(y[0], y[1]); w.y = cvt_pk_bf16(y[2], y[3]); *(u32x2*)(Xb + (size_t)row2 * DM + 4 * lane + 256 * j) = w; } } }
    }
}

__device__ __forceinline__ int swz(int row, int chunk) { return row * 256 + ((chunk ^ (row & 15)) << 4); }
#define MFMA32(a, b, c) __builtin_amdgcn_mfma_f32_32x32x16_bf16((a), (b), (c), 0, 0, 0)

#define XB_TMO      128
#define XB_XCNT(j)  (256  + 64 * (j))
#define XB_XSUB(j)  (1280 + 64 * (j))
#define XB_XGEN(j)  (2304 + 64 * (j))
#define XB_TOP      3328
#define XB_TOPGEN   3392
#define XCD_BAR_WORDS 3456
#define XB_SPIN_CAP (1u << 18)
__device__ __forceinline__ unsigned xb_ld(unsigned* p)              { return __hip_atomic_load(p, __ATOMIC_RELAXED, __HIP_MEMORY_SCOPE_AGENT); }
__device__ __forceinline__ unsigned xb_add(unsigned* p, unsigned v) { return __hip_atomic_fetch_add(p, v, __ATOMIC_RELAXED, __HIP_MEMORY_SCOPE_AGENT); }
__device__ __forceinline__ unsigned xb_xcc_id() { return (unsigned)__builtin_amdgcn_s_getreg((3 << 11) | 20) & 0xFu; }
#define XB_SPIN(cond, bar) do { unsigned _sp = 0; while (cond) { \
    if ((++_sp & 255u) == 0u) { if (xb_ld(&(bar)[XB_TMO])) break; if (_sp > XB_SPIN_CAP) { atomicAdd(&(bar)[XB_TMO], 1u); break; } } } } while (0)
struct XcdBarrier { unsigned* bar; unsigned x; volatile LAS unsigned* st; };
__device__ __forceinline__ XcdBarrier xcd_barrier_post(unsigned* bar, volatile LAS unsigned* st) {
    XcdBarrier b; b.bar = bar; b.x = xb_xcc_id(); b.st = st;
    if (threadIdx.x == 0) (void)xb_add(&bar[XB_XCNT(b.x)], 1u);
    return b;
}
__device__ __forceinline__ void xcd_barrier_complete(unsigned* bar, unsigned x, unsigned& nloc, unsigned& nx) {
    const unsigned G = gridDim.x * gridDim.y * gridDim.z;
    unsigned sum, cnt, mine, sp = 0u;
    for (;;) {
        sum = 0u; cnt = 0u; mine = 0u;
#pragma unroll
        for (unsigned j = 0; j < 16; ++j) { const unsigned c = xb_ld(&bar[XB_XCNT(j)]); sum += c; cnt += (c > 0u) ? 1u : 0u; mine = (j == x) ? c : mine; }
        if (sum == G) break;
        __builtin_amdgcn_s_sleep(1);
        if ((++sp & 255u) == 0u) { if (xb_ld(&bar[XB_TMO])) break; if (sp > XB_SPIN_CAP) { atomicAdd(&bar[XB_TMO], 1u); break; } }
    }
    nloc = mine > 0u ? mine : 1u; nx = cnt > 0u ? cnt : 1u;
}
__device__ __forceinline__ void xcd_barrier(const XcdBarrier& b) {
    asm volatile("s_waitcnt vmcnt(0)" ::: "memory");
    __syncthreads();
    if (threadIdx.x == 0) {
        unsigned* bar = b.bar;
        __builtin_amdgcn_s_waitcnt(0);
        unsigned nloc = b.st[0], nx = b.st[1];
        if (nloc == 0u) { xcd_barrier_complete(bar, b.x, nloc, nx); b.st[0] = nloc; b.st[1] = nx; }
        const unsigned old = xb_add(&bar[XB_XSUB(b.x)], 1u);
        const unsigned gen = old / nloc;
        if (old + 1u == (gen + 1u) * nloc) {
            __builtin_amdgcn_fence(__ATOMIC_RELEASE, "agent");
            asm volatile("s_waitcnt vmcnt(0)" ::: "memory");
            const unsigned og = xb_add(&bar[XB_TOP], 1u);
            const unsigned tg = og / nx;
            if (og + 1u == (tg + 1u) * nx) xb_add(&bar[XB_TOPGEN], 1u);
            else XB_SPIN(xb_ld(&bar[XB_TOPGEN]) == tg, bar);
            __builtin_amdgcn_fence(__ATOMIC_ACQUIRE, "agent");
            xb_add(&bar[XB_XGEN(b.x)], 1u);
            asm volatile("s_waitcnt vmcnt(0)" ::: "memory");
        } else {
            XB_SPIN(xb_ld(&bar[XB_XGEN(b.x)]) == gen, bar);
            __builtin_amdgcn_fence(__ATOMIC_ACQUIRE, "agent");
            asm volatile("s_waitcnt vmcnt(0)" ::: "memory");
        }
    }
    __syncthreads();
}
constexpr size_t OFF_BAR = OFF_CVEC + CVEC_BYTES;
static_assert(OFF_BAR % 256 == 0 && OFF_BAR + XCD_BAR_WORDS * 4 <= 64 * MiB, "barrier words");
constexpr int LDS_ST_OFF = 147456;

__global__ void __launch_bounds__(512, 2) fwd_kernel(Params p) {
    extern __shared__ __attribute__((aligned(16))) unsigned char lds_raw[];
    LAS unsigned char* lds = (LAS unsigned char*)lds_raw;
    if (p.ws == nullptr) cg::this_grid().sync();
    if (threadIdx.x < 4) *(volatile LAS unsigned*)(lds + LDS_ST_OFF + 4 * threadIdx.x) = 0u;
    __syncthreads();
    const XcdBarrier xbar = xcd_barrier_post((unsigned*)(p.ws + OFF_BAR), (volatile LAS unsigned*)(lds + LDS_ST_OFF));
    const int G = gridDim.x, bx = blockIdx.x;
#define GSYNC() xcd_barrier(xbar)
#define PHASE_IDS int tid = threadIdx.x; asm volatile("" : "+v"(tid)); const int lane = tid & 63, wave = __builtin_amdgcn_readfirstlane(tid >> 6); const int gw = bx * 8 + wave, NGW = G * 8; (void)gw; (void)NGW; (void)lane;
    unsigned char* ws = p.ws;
    const float* x = p.in[0];
    float* C1IN = (float*)(ws + OFF_CVEC); float* C2IN = C1IN + INW; float* C1F2 = C2IN + INW; float* C2F2 = C1F2 + 2 * DFF;
    f32x2* STATP1 = (f32x2*)(ws + OFF_STATP1); f32x2* STATP2 = (f32x2*)(ws + OFF_STATP2);
    unsigned long long* XBUF = (unsigned long long*)(ws + OFF_XBUF); unsigned* PCNT = (unsigned*)(ws + OFF_CVEC + (size_t)(2 * INW + 4 * DFF) * 4);
    bf16_t* W1GU = (bf16_t*)(ws + OFF_W1GU); bf16_t* W1D = (bf16_t*)(ws + OFF_W1D); bf16_t* WIN = (bf16_t*)(ws + OFF_WIN); bf16_t* WRO = (bf16_t*)(ws + OFF_WRO);
    bf16_t* WCO = (bf16_t*)(ws + OFF_WCO); bf16_t* WOUT = (bf16_t*)(ws + OFF_WOUT); bf16_t* W2GU = (bf16_t*)(ws + OFF_W2GU); bf16_t* W2D = (bf16_t*)(ws + OFF_W2D);
    bf16_t* XB = (bf16_t*)(ws + SLOTP(0));
    bf16_t* HB = (bf16_t*)(ws + SLOTP(1));
    float* TRES = p.out;
    bf16_t* VT = (bf16_t*)(ws + SLOTP(2));
    bf16_t* SNAP = (bf16_t*)(ws + SLOTP(5));
    bf16_t* QB = (bf16_t*)(ws + SLOTP(1)); bf16_t* KB = (bf16_t*)(ws + SLOTP(4));
    bf16_t* UB = (bf16_t*)(ws + SLOTP(1)); bf16_t* GRB = (bf16_t*)(ws + SLOTP(2)); bf16_t* GCB = (bf16_t*)(ws + SLOTP(3));
    bf16_t* ACB = (bf16_t*)(ws + SLOTP(4));
    bf16_t* T1 = (bf16_t*)(ws + SLOTP(1));
    bf16_t* MGB = GRB;

    for (int rep = 0; rep < REP_P0; ++rep) {
        PHASE_IDS
        LAS float* scr = (LAS float*)(lds + wave * 8448);
        constexpr int NI0 = 16 * 176, NI1 = 44 * 32, NI2 = 16 * 320, NI3 = 32 * 32, NI4 = 16 * 32;
        constexpr int NITEMS = 2 * NI0 + 2 * NI1 + NI2 + NI3 + 2 * NI4;
        for (int it = gw; it < NITEMS; it += NGW) {
            int r = it;
            if (r < 2 * NI0) { const int l2 = r >= NI0; r -= l2 * NI0; const int kb = r / 176, nb = r % 176, n0 = nb * 32, t = n0 >> 8, pp = n0 & 255;
                const float* src = p.in[l2 ? (pp < 128 ? 18 : 19) : (pp < 128 ? 1 : 2)] + 128 * t + (pp & 127);
                if (l2) transpose_item(src, DFF, DM, W2GU + (size_t)n0 * DM, kb * 64, scr, lane, p.in[16], p.in[17], C1F2 + n0, C2F2 + n0, nullptr);
                else transpose_item(src, DFF, DM, W1GU + (size_t)n0 * DM, kb * 64, scr, lane);
                continue; }
            r -= 2 * NI0;
            if (r < 2 * NI1) { const int l2 = r >= NI1; r -= l2 * NI1; const int kb = r / 32, nb = r % 32;
                transpose_item(p.in[l2 ? 20 : 3] + nb * 32, DM, DFF, (l2 ? W2D : W1D) + (size_t)nb * 32 * DFF, kb * 64, scr, lane); continue; }
            r -= 2 * NI1;
            if (r < NI2) { const int kb = r / 320, nb = r % 320, n0 = nb * 32;
                transpose_item(p.in[6] + win_src_col(n0), INW, DM, WIN + (size_t)n0 * DM, kb * 64, scr, lane, p.in[4], p.in[5], C1IN + n0, C2IN + n0, p.in[7] + win_src_col(n0)); continue; }
            r -= NI2;
            if (r < NI3) { const int kb = r / 32, nb = r % 32;
                transpose_item(p.in[13] + nb * 32, DM, 2048, WRO + (size_t)nb * 32 * 2048, kb * 64, scr, lane); continue; }
            r -= NI3;
            { const int l2 = r >= NI4; r -= l2 * NI4; const int kb = r / 32, nb = r % 32;
                transpose_item(p.in[l2 ? 15 : 14] + nb * 32, DM, DM, (l2 ? WOUT : WCO) + (size_t)nb * 32 * DM, kb * 64, scr, lane); }
        }
        const int gt = bx * 512 + tid, NGT = G * 512;
        for (size_t i = gt; i < (size_t)MTOK * DM / 8; i += (size_t)4 * NGT) {
            f32x4 a[4], b[4];
#pragma unroll
            for (int q = 0; q < 4; ++q) { const size_t j = i + (size_t)q * NGT; a[q] = *(const f32x4*)(x + j * 8); b[q] = *(const f32x4*)(x + j * 8 + 4); }
#pragma unroll
            for (int q = 0; q < 4; ++q) { const size_t j = i + (size_t)q * NGT; *(u32x4*)(XB + j * 8) = pack8(a[q], b[q]); } }
    }
    GSYNC();
    pg8::StaticOrder S;
    { pg8::Gemm g{XB, W1GU, DM, DM, DM}; S.init(MTOK, 2 * DFF, G, bx); pg8::EpiGU<false> E{HB, nullptr, nullptr, nullptr}; pg8::gemm_phase<pg8::EpiGU<false>, 0>(lds, g, S, E); }
    GSYNC();
    { pg8::Gemm g{HB, W1D, DFF, DFF, DFF}; S.init(MTOK, DM, G, bx); pg8::EpiResLn<0> E{x, XB, STATP1, nullptr, nullptr, nullptr, 0.5f}; pg8::gemm_phase<pg8::EpiResLn<0>, 0>(lds, g, S, E); }
    GSYNC();
    { pg8::Gemm g{WIN + (size_t)2048 * DM, XB, DM, DM, DM}; S.init(2048, MTOK, G, bx); pg8::EpiVT E{VT, STATP1, C1IN + 2048, C2IN + 2048}; pg8::gemm_phase<pg8::EpiVT, 0>(lds, g, S, E); }
    { pg8::Gemm g{XB, WIN, DM, DM, DM}; S.init(MTOK, 2048, G, bx); pg8::EpiQK E{QB, KB, STATP1, C1IN, C2IN}; pg8::gemm_phase<pg8::EpiQK, 0>(lds, g, S, E); }
    GSYNC();
    for (int rep = 0; rep < REP_R1; ++rep) {
        PHASE_IDS
        const int lr = lane & 31, lh = lane >> 5;
        for (int it0 = bx; it0 < 256; it0 += G) {
            const int item = (G == 256) ? ((it0 & 7) * 32 + (it0 >> 3)) : it0;
            const int bh = item >> 2, es = item & 3, h = bh & 7, db = wave >> 1, eb = wave & 1;
            const float decay = exp2f(128.0f * log2gamma(h));
            f32x16 st; for (int r = 0; r < 16; ++r) st[r] = 0.f;
            unsigned ktr0, ktr1;
            { const int g = lane >> 4, q = (lane >> 2) & 3, pp = lane & 3, chk = 4 * db + 2 * (g & 1) + (pp >> 1);
              const int r0 = 8 * (g >> 1) + q, r1 = r0 + 4;
              ktr0 = (unsigned)(256 * r0 + 16 * (chk ^ (((r0 & 3) << 2) | ((r0 >> 2) & 3))) + 8 * (pp & 1));
              ktr1 = (unsigned)(256 * r1 + 16 * (chk ^ (((r1 & 3) << 2) | ((r1 >> 2) & 3))) + 8 * (pp & 1)); }
            const char* ksrc = (const char*)(KB + (size_t)bh * SEQ * DK);
            const int krow = lane >> 4, kslot = lane & 15;
            const char* vsrc = (const char*)(VT + ((size_t)(bh * 32) * 8 + 2 * es) * 4096) + lane * 16;
#define R1_ISSUE(n) do { const unsigned sbase = (unsigned)((n) % 3) * 49152u; _Pragma("unroll") for (int pc = 0; pc < 6; ++pc) { const int piece = wave * 6 + pc; \
            const char* gsrc = piece < 32 ? ksrc + (size_t)(n) * 32768 + (4 * piece + krow) * 256 + ((kslot ^ ((krow << 2) | (piece & 3))) << 4) : vsrc + (size_t)(n) * 65536 + (piece - 32) * 1024; \
            __builtin_amdgcn_global_load_lds((const unsigned*)gsrc, (LAS unsigned*)(lds + sbase + piece * 1024), 16, 0, 0); } } while (0)
            R1_ISSUE(0); R1_ISSUE(1);
            asm volatile("s_waitcnt vmcnt(6)" ::: "memory");
            for (int n = 0; n < 31; ++n) {
                asm volatile("s_waitcnt vmcnt(6)\n\ts_waitcnt lgkmcnt(0)" ::: "memory");
                __builtin_amdgcn_s_barrier();
                asm volatile("" ::: "memory"); __builtin_amdgcn_sched_barrier(0);
                if (n + 2 < 31) R1_ISSUE(n + 2);
                const LAS unsigned char* sb = lds + (unsigned)(n % 3) * 49152u;
                bf16x8 kf[8], vf[8];
#pragma unroll
                for (int ks = 0; ks < 8; ++ks) {
                    const s16x4 lo = __builtin_amdgcn_ds_read_tr16_b64_v4i16((LAS s16x4*)(sb + ktr0 + ks * 4096)), hi = __builtin_amdgcn_ds_read_tr16_b64_v4i16((LAS s16x4*)(sb + ktr1 + ks * 4096));
                    kf[ks] = __builtin_shufflevector(lo, hi, 0, 1, 2, 3, 4, 5, 6, 7);
                    vf[ks] = *(const LAS bf16x8*)(sb + 32768 + (eb * 8 + ks) * 1024 + lane * 16); }
                st = st * decay;
#pragma unroll
                for (int ks = 0; ks < 8; ++ks) st = MFMA32(kf[ks], vf[ks], st);
#pragma unroll
                for (int k = 0; k < 4; k += 2) {
                    u32x2 a, b; a.x = cvt_pk_bf16(st[4 * k], st[4 * k + 1]); a.y = cvt_pk_bf16(st[4 * k + 2], st[4 * k + 3]); b.x = cvt_pk_bf16(st[4 * k + 4], st[4 * k + 5]); b.y = cvt_pk_bf16(st[4 * k + 6], st[4 * k + 7]);
                    { auto r = __builtin_amdgcn_permlane32_swap(a.x, b.x, false, false); a.x = r[0]; b.x = r[1]; } { auto r = __builtin_amdgcn_permlane32_swap(a.y, b.y, false, false); a.y = r[0]; b.y = r[1]; }
                    *(u32x4*)(SNAP + ((((size_t)(bh * 32 + n + 1) * 8 + 2 * es + eb) * 8 + 2 * db + (k >> 1)) * 64 + lh * 32 + lr) * 8) = (u32x4){a.x, a.y, b.x, b.y}; }
            }
#undef R1_ISSUE
            asm volatile("s_waitcnt vmcnt(0)" ::: "memory");
            __syncthreads();
        }
    }
    GSYNC();
    {
        PHASE_IDS
        const int w = wave;
        LAS unsigned char* Qs = lds; LAS unsigned char* Ks = lds + 32768; LAS unsigned char* Ps = lds + 65536; LAS f32x2* STAT = (LAS f32x2*)(lds + 98304);
        u32x4 qv[4], kv[4]; bf16x8 stf[8], vtf[8];
#define R2_LOAD_QK(it) do { const u32x4* qsrc_ = (const u32x4*)(QB + (size_t)(it) * 128 * DK); const u32x4* ksrc_ = (const u32x4*)(KB + (size_t)(it) * 128 * DK); \
            _Pragma("unroll") for (int k = 0; k < 4; ++k) { qv[k] = qsrc_[tid + 512 * k]; kv[k] = ksrc_[tid + 512 * k]; } } while (0)
#define R2_LOAD_ST(it) do { _Pragma("unroll") for (int ks = 0; ks < 8; ++ks) stf[ks] = *(const bf16x8*)(SNAP + (((size_t)(it) * 8 + w) * 8 + ks) * 512 + lane * 8); } while (0)
#define R2_LOAD_VT(it) do { _Pragma("unroll") for (int ks = 0; ks < 8; ++ks) vtf[ks] = *(const bf16x8*)(VT + (((size_t)(it) * 8 + w) * 8 + ks) * 512 + lane * 8); } while (0)
        if (bx < 2048) { R2_LOAD_QK(bx); if ((bx & 31) > 0) R2_LOAD_ST(bx); R2_LOAD_VT(bx); }
        for (int item = bx; item < 2048; item += G) {
            const int bh = item >> 5, n = item & 31, h = bh & 7; const float lg = log2gamma(h);
            const int nxt = item + G; const bool has_nxt = nxt < 2048;
            int lane_i = lane; asm volatile("" : "+v"(lane_i));
            const int lr = lane_i & 31, lh = lane_i >> 5;
#pragma unroll
            for (int k = 0; k < 4; ++k) { const int idx = tid + 512 * k, row = idx >> 4, ch = idx & 15; *(LAS u32x4*)(Qs + swz(row, ch)) = qv[k]; *(LAS u32x4*)(Ks + swz(row, ch)) = kv[k]; }
            __syncthreads();
            { const int ib = w >> 1;
#pragma unroll
              for (int tt = 0; tt < 2; ++tt) { const int jb = 2 * (w & 1) + tt;
                if (jb <= ib) { f32x16 sa; for (int r = 0; r < 16; ++r) sa[r] = 0.f;
#pragma unroll
                    for (int ks = 0; ks < 8; ++ks) { const bf16x8 a = *(const LAS bf16x8*)(Ks + swz(32 * jb + lr, 2 * ks + lh)); const bf16x8 bq = *(const LAS bf16x8*)(Qs + swz(32 * ib + lr, 2 * ks + lh)); sa = MFMA32(a, bq, sa); }
                    const int i = 32 * ib + lr; const float rowf = exp2f((float)(i - 127) * lg);
#pragma unroll
                    for (int g4 = 0; g4 < 4; ++g4) { const int j0 = 32 * jb + 8 * g4 + 4 * lh; float pv[4];
#pragma unroll
                        for (int xx = 0; xx < 4; ++xx) { const int dd = i - j0 - xx; pv[xx] = dd >= 0 ? sa[4 * g4 + xx] * rowf : 0.f; }
                        u32x2 wv; wv.x = cvt_pk_bf16(pv[0], pv[1]); wv.y = cvt_pk_bf16(pv[2], pv[3]);
                        *(LAS u32x2*)(Ps + i * 256 + (((j0 >> 3) ^ (i & 15)) << 4) + (j0 & 7) * 2) = wv; } } } }
            f32x16 acc[4];
#pragma unroll
            for (int q = 0; q < 4; ++q) for (int r = 0; r < 16; ++r) acc[q][r] = 0.f;
            if (n > 0) {
#pragma unroll
                for (int q = 0; q < 4; ++q) {
#pragma unroll
                    for (int ks = 0; ks < 8; ++ks) { const bf16x8 bq = *(const LAS bf16x8*)(Qs + swz(32 * q + lr, 2 * ks + lh)); acc[q] = MFMA32(stf[ks], bq, acc[q]); }
                    acc[q] = acc[q] * exp2f((float)(32 * q + lr + 1) * lg); }
            }
            if (has_nxt && (nxt & 31) > 0) R2_LOAD_ST(nxt);
            __syncthreads();
            if (has_nxt) R2_LOAD_QK(nxt);
#pragma unroll
            for (int q = 0; q < 4; ++q) {
#pragma unroll
                for (int ks = 0; ks < 2 * (q + 1); ++ks) { const bf16x8 bp = *(const LAS bf16x8*)(Ps + swz(32 * q + lr, 2 * ks + lh)); acc[q] = MFMA32(vtf[ks], bp, acc[q]); } }
            if (has_nxt) R2_LOAD_VT(nxt);
#pragma unroll
            for (int q = 0; q < 4; ++q) { float s1 = 0.f, s2 = 0.f;
#pragma unroll
                for (int r = 0; r < 16; ++r) { s1 += acc[q][r]; s2 += acc[q][r] * acc[q][r]; }
                s1 += __shfl_xor(s1, 32); s2 += __shfl_xor(s2, 32);
                if (lh == 0) STAT[w * 128 + 32 * q + lr] = (f32x2){s1, s2}; }
            __syncthreads();
            f32x4 gnv[4];
#pragma unroll
            for (int g4 = 0; g4 < 4; ++g4) gnv[g4] = *(const f32x4*)(p.in[8] + h * DV + 32 * w + 8 * g4 + 4 * lh);
#pragma unroll
            for (int q = 0; q < 4; ++q) { const int i = 32 * q + lr; float s1 = 0.f, s2 = 0.f;
#pragma unroll
                for (int w2 = 0; w2 < 8; ++w2) { const f32x2 t = STAT[w2 * 128 + i]; s1 += t[0]; s2 += t[1]; }
                const float mean = s1 * (1.f / DV); const float var = fmaxf(s2 * (1.f / DV) - mean * mean, 0.f); const float rstd = 1.0f / sqrtf(var + LN_EPS);
                bf16_t* orow = SNAP + ((size_t)(bh * SEQ + 128 * n + i)) * DV + 32 * w + 8 * lh;
                u32x2 wv[4];
#pragma unroll
                for (int g4 = 0; g4 < 4; ++g4) { wv[g4].x = cvt_pk_bf16((acc[q][4 * g4] - mean) * rstd * gnv[g4][0], (acc[q][4 * g4 + 1] - mean) * rstd * gnv[g4][1]);
                    wv[g4].y = cvt_pk_bf16((acc[q][4 * g4 + 2] - mean) * rstd * gnv[g4][2], (acc[q][4 * g4 + 3] - mean) * rstd * gnv[g4][3]); }
#pragma unroll
                for (int k = 0; k < 4; k += 2) { u32x2 a = wv[k], b = wv[k + 1];
                    { auto r = __builtin_amdgcn_permlane32_swap(a.x, b.x, false, false); a.x = r[0]; b.x = r[1]; } { auto r = __builtin_amdgcn_permlane32_swap(a.y, b.y, false, false); a.y = r[0]; b.y = r[1]; }
                    *(u32x4*)(orow + 8 * k) = (u32x4){a.x, a.y, b.x, b.y}; } }
        }
    }
    GSYNC();
    { pg8::Gemm g{XB, WIN + (size_t)4096 * DM, DM, DM, DM}; S.init(MTOK, 6144, G, bx);
      pg8::EpiGUG E{pg8::EpiG{SNAP, STATP1, C1IN + 4096, C2IN + 4096}, pg8::EpiU{UB, STATP1, C1IN + 6144, C2IN + 6144}, pg8::EpiGates{GRB, GCB, STATP1, C1IN + 8192, C2IN + 8192}};
      pg8::gemm_phase<pg8::EpiGUG, 0>(lds, g, S, E); }
    GSYNC();
    for (int rep = 0; rep < REP_CONV; ++rep) {
        PHASE_IDS
        LAS float* Y = (LAS float*)lds;
        LAS float* GB = (LAS float*)(lds + 131072);
        const int c2 = 2 * tid; const unsigned coff4 = (unsigned)c2 * 4u, coff2 = (unsigned)c2 * 2u;
        *(LAS f32x2*)(GB + c2) = *(const f32x2*)((const char*)p.in[11] + coff4); *(LAS f32x2*)(GB + DM + c2) = *(const f32x2*)((const char*)p.in[12] + coff4);
        for (int item = bx; item < 256; item += G) {
            const int tb = 128 * item, sstart = tb & (SEQ - 1);
            f32x2 wk[31];
#pragma unroll
            for (int tp = 0; tp < 31; ++tp) { const float* wp = p.in[9] + tp * DM; asm volatile("" : "+s"(wp)); wk[tp] = *(const f32x2*)((const char*)wp + coff4); }
            const f32x2 cbias = *(const f32x2*)((const char*)p.in[10] + coff4);
            f32x2 win[46]; unsigned nx[16];
#pragma unroll
            for (int q = 0; q < 16; ++q) nx[q] = *(const unsigned*)((const char*)(UB + (size_t)(tb + q) * DM) + coff2);
#pragma unroll
            for (int q = 0; q < 30; ++q) { unsigned uu = 0u; if (sstart != 0) uu = *(const unsigned*)((const char*)(UB + (size_t)(tb - 30 + q) * DM) + coff2); win[q] = (f32x2){bf_lo(uu), bf_hi(uu)}; }
#define CONV_FMA(sbv) do { const int t0_ = tb + 16 * (sbv); LAS float* Yw = Y + ((sbv) & 1) * 16 * DM; \
                _Pragma("unroll") for (int q = 0; q < 16; ++q) win[30 + q] = (f32x2){bf_lo(nx[q]), bf_hi(nx[q])}; \
                _Pragma("unroll") for (int q = 0; q < 16; ++q) nx[q] = *(const unsigned*)((const char*)(UB + (size_t)(t0_ + 16 + q) * DM) + coff2);     \
                _Pragma("unroll") for (int q = 0; q < 16; ++q) { f32x2 a = cbias; _Pragma("unroll") for (int tp = 0; tp < 31; ++tp) a += wk[tp] * win[q + tp]; *(LAS f32x2*)(Yw + q * DM + c2) = a; } \
                _Pragma("unroll") for (int q = 0; q < 30; ++q) win[q] = win[q + 16]; } while (0)
#define CONV_LN(sbv) do { const int t0_ = tb + 16 * (sbv); const LAS float* Yr = Y + ((sbv) & 1) * 16 * DM; \
                _Pragma("unroll") for (int tk = 0; tk < 2; ++tk) { const int tok = wave + 8 * tk; const LAS float* yr = Yr + tok * DM + 4 * lane; f32x4 v[4]; float s1 = 0.f, s2 = 0.f; \
                  _Pragma("unroll") for (int j = 0; j < 4; ++j) { v[j] = *(const LAS f32x4*)(yr + 256 * j); s1 += (v[j][0] + v[j][1]) + (v[j][2] + v[j][3]); s2 += (v[j][0] * v[j][0] + v[j][1] * v[j][1]) + (v[j][2] * v[j][2] + v[j][3] * v[j][3]); } \
                  wave_sum2(s1, s2); \
                  const float mean = s1 * (1.f / DM); const float rstd = 1.0f / sqrtf(fmaxf(s2 * (1.f / DM) - mean * mean, 0.f) + LN_EPS); \
                  _Pragma("unroll") for (int j = 0; j < 4; ++j) { const f32x4 lgj = *(const LAS f32x4*)(GB + 4 * lane + 256 * j), lbj = *(const LAS f32x4*)(GB + DM + 4 * lane + 256 * j); f32x4 y = (v[j] - mean) * rstd * lgj + lbj; \
                      _Pragma("unroll") for (int e = 0; e < 4; ++e) y[e] = siluf_(y[e]); \
                      u32x2 wv; wv.x = cvt_pk_bf16(y[0], y[1]); wv.y = cvt_pk_bf16(y[2], y[3]); *(u32x2*)(ACB + (size_t)(t0_ + tok) * DM + 4 * lane + 256 * j) = wv; } } } while (0)
            CONV_FMA(0);
            __syncthreads();
            for (int sb = 1; sb < 8; ++sb) { CONV_LN(sb - 1); CONV_FMA(sb); __syncthreads(); }
            CONV_LN(7);
#undef CONV_FMA
#undef CONV_LN
            __syncthreads();
        }
    }
    GSYNC();
    { pg8::Gemm g{SNAP, WRO, DV, 2048, 2048}; S.init(MTOK, DM, G, bx); pg8::EpiRO E{GRB, T1}; pg8::gemm_phase<pg8::EpiRO, 1>(lds, g, S, E); }
    { pg8::Gemm g{ACB, WCO, DM, DM, DM}; S.init(MTOK, DM, G, bx); pg8::EpiCO E{GCB, T1, MGB}; pg8::gemm_phase<pg8::EpiCO, 0>(lds, g, S, E); }
    GSYNC();
    { pg8::Gemm g{MGB, WOUT, DM, DM, DM}; S.init(MTOK, DM, G, bx); pg8::EpiResLn<1> E{nullptr, XB, STATP2, STATP1, p.in[4], p.in[5], 1.0f}; pg8::gemm_phase<pg8::EpiResLn<1>, 0>(lds, g, S, E); }
    GSYNC();
    { pg8::Gemm g{XB, W2GU, DM, DM, DM}; S.init(MTOK, 2 * DFF, G, bx); pg8::EpiGU<true> E{HB, STATP2, C1F2, C2F2}; pg8::gemm_phase<pg8::EpiGU<true>, 0>(lds, g, S, E); }
    GSYNC();
    { pg8::Gemm g{HB, W2D, DFF, DFF, DFF}; S.init(MTOK, DM, G, bx); pg8::EpiFinalLn E{p.out, XB, STATP2, p.in[16], p.in[17], 0.5f, XBUF, PCNT, p.in[21], p.in[22]}; pg8::gemm_phase<pg8::EpiFinalLn, 0>(lds, g, S, E); }
}

extern "C" void kernel_launch(void* const* d_in, const int* in_sizes, int n_in, void* d_out, int out_size, void* d_ws, size_t ws_size, hipStream_t stream) {
    static int grid = 0;
    if (grid == 0) {
        if (n_in != 23 || out_size != MTOK * DM || ws_size < WS_NEED) { fprintf(stderr, "kernel_launch: unexpected problem (n_in %d, out %d, ws %zu)\n", n_in, out_size, ws_size); grid = -1; return; }
        int dev = 0, cus = 0, per_cu = 0;
        hipGetDevice(&dev); hipDeviceGetAttribute(&cus, hipDeviceAttributeMultiprocessorCount, dev);
        if (hipFuncSetAttribute((const void*)fwd_kernel, hipFuncAttributeMaxDynamicSharedMemorySize, LDS_BYTES) != hipSuccess) { fprintf(stderr, "kernel_launch: hipFuncSetAttribute failed\n"); grid = -1; return; }
        if (hipOccupancyMaxActiveBlocksPerMultiprocessor(&per_cu, (const void*)fwd_kernel, 512, LDS_BYTES) != hipSuccess || per_cu < 1) { fprintf(stderr, "kernel_launch: occupancy query gives %d\n", per_cu); per_cu = 1; }
        (void)hipGetLastError();
        grid = cus;
    }
    if (grid < 0) return;
    Params p{};
    for (int i = 0; i < 23; ++i) p.in[i] = (const float*)d_in[i];
    p.out = (float*)d_out; p.ws = (unsigned char*)d_ws;
    (void)hipMemsetAsync((char*)d_ws + OFF_CVEC, 0, CVEC_BYTES + XCD_BAR_WORDS * 4, stream);
    void* args[] = {&p};
    hipError_t e = hipLaunchCooperativeKernel((const void*)fwd_kernel, dim3(grid), dim3(512), args, LDS_BYTES, stream);
    if (e != hipSuccess) fprintf(stderr, "kernel_launch: cooperative launch failed: %s (grid %d)\n", hipGetErrorString(e), grid);
}
```
